# Optimizing an MI355X kernel written in HIP

```python
import jax, jax.numpy as jnp
from jax import lax
import numpy as np

D_MODEL = 2048
BATCH = 4
SEQ = 2048
DEPTH = 1

N_META = 16
HEAD_DIM = 64
N_Q_HEADS = D_MODEL // HEAD_DIM
N_KV_HEADS = N_Q_HEADS // 8
Q_PER_KV = N_Q_HEADS // N_KV_HEADS
ATTN_W = N_Q_HEADS * HEAD_DIM
KV_W = N_KV_HEADS * HEAD_DIM
WINDOW = 128
BLOCK = 128
LRU_WIDTH = D_MODEL
LRU_BLOCKS = 8
LRU_BLOCK_W = LRU_WIDTH // LRU_BLOCKS
CONV_W = 4
LRU_C = 8.0
D_FF = 4 * D_MODEL
EPS = 1e-6
NEG = -1e30
IN_SIZES = (ATTN_W, KV_W, KV_W, LRU_WIDTH, LRU_WIDTH, D_MODEL, D_MODEL)
IN_W = sum(IN_SIZES)
IN_SPLITS = [int(s) for s in np.cumsum(IN_SIZES)[:-1]]

kernel_name = "hybrid_swa_sink_rglru_sqrelu_block"


def rmsnorm(x, g):
    xf = x.astype(jnp.float32)
    y = xf * lax.rsqrt(jnp.mean(xf * xf, axis=-1, keepdims=True) + EPS)
    return (y * g.astype(jnp.float32)).astype(x.dtype)


def sink_softmax(logits, sink):
    m = jnp.maximum(jnp.max(logits, axis=-1, keepdims=True), sink)
    p = jnp.exp(logits - m)
    den = jnp.sum(p, axis=-1, keepdims=True) + jnp.exp(sink - m)
    return p / den


def with_prev_block(t):
    prev = jnp.pad(t, ((0, 0), (1, 0), (0, 0), (0, 0), (0, 0)))[:, :-1]
    return jnp.concatenate([prev, t], axis=2)


def sliding_window_attention(q, k, v, sink):
    B, T = q.shape[0], q.shape[1]
    S = T - N_META
    nb = S // BLOCK
    scale = HEAD_DIM ** -0.5
    dt = v.dtype
    q = q.reshape(B, T, N_KV_HEADS, Q_PER_KV, HEAD_DIM)
    qm, qr = q[:, :N_META], q[:, N_META:]
    km, kr = k[:, :N_META], k[:, N_META:]
    vm, vr = v[:, :N_META], v[:, N_META:]
    sink = sink.astype(jnp.float32).reshape(N_KV_HEADS, Q_PER_KV)

    sm = jnp.einsum('bqkgd,bskd->bkgqs', qm, km).astype(jnp.float32) * scale
    causal = jnp.tril(jnp.ones((N_META, N_META), dtype=bool))
    sm = jnp.where(causal, sm, NEG)
    pm = sink_softmax(sm, sink[None, :, :, None, None])
    om = jnp.einsum('bkgqs,bskd->bqkgd', pm.astype(dt), vm).reshape(B, N_META, ATTN_W)

    qb = qr.reshape(B, nb, BLOCK, N_KV_HEADS, Q_PER_KV, HEAD_DIM)
    kw = with_prev_block(kr.reshape(B, nb, BLOCK, N_KV_HEADS, HEAD_DIM))
    vw = with_prev_block(vr.reshape(B, nb, BLOCK, N_KV_HEADS, HEAD_DIM))
    s_loc = jnp.einsum('bnqkgd,bnskd->bnkgqs', qb, kw).astype(jnp.float32) * scale
    s_met = jnp.einsum('bnqkgd,bmkd->bnkgqm', qb, km).astype(jnp.float32) * scale
    iq = jnp.arange(BLOCK)[:, None]
    ik = jnp.arange(2 * BLOCK)[None, :]
    rel = iq + BLOCK - ik
    band = (rel >= 0) & (rel < WINDOW)
    blk = jnp.arange(nb)[:, None, None]
    valid = band[None] & ((blk > 0) | (ik >= BLOCK)[None])
    s_loc = jnp.where(valid[None, :, None, None], s_loc, NEG)
    logits = jnp.concatenate([s_met, s_loc], axis=-1)
    p = sink_softmax(logits, sink[None, None, :, :, None, None]).astype(dt)
    o = (jnp.einsum('bnkgqm,bmkd->bnqkgd', p[..., :N_META], vm)
         + jnp.einsum('bnkgqs,bnskd->bnqkgd', p[..., N_META:], vw))
    o = o.reshape(B, S, ATTN_W)
    return jnp.concatenate([om, o], axis=1)


def causal_depthwise_conv(x, w, b):
    T = x.shape[1]
    xp = jnp.pad(x, ((0, 0), (CONV_W - 1, 0), (0, 0)))
    y = b
    for tap in range(CONV_W):
        y = y + xp[:, tap:tap + T] * w[tap]
    return y


def rg_lru(x, w_a, b_a, w_i, b_i, lam):
    B, T, W = x.shape
    xb = x.reshape(B, T, LRU_BLOCKS, LRU_BLOCK_W)
    r = jax.nn.sigmoid(jnp.einsum('btnc,ncd->btnd', xb, w_a).reshape(B, T, W) + b_a)
    i = jax.nn.sigmoid(jnp.einsum('btnc,ncd->btnd', xb, w_i).reshape(B, T, W) + b_i)
    log_a = -LRU_C * r.astype(jnp.float32) * jax.nn.softplus(-lam.astype(jnp.float32))
    a = jnp.exp(log_a)
    mult = jnp.sqrt(-jnp.expm1(2.0 * log_a))
    mult = jnp.where(jnp.arange(T)[None, :, None] == 0, 1.0, mult)
    bterm = mult * (i * x).astype(jnp.float32)

    def combine(lhs, rhs):
        return (lhs[0] * rhs[0], rhs[0] * lhs[1] + rhs[1])

    _, h = lax.associative_scan(combine, (a, bterm), axis=1)
    return h.astype(x.dtype)


def setup_inputs(seed: int = 0) -> dict:
    key = jax.random.key(seed)
    ks = jax.random.split(key, 24)
    f32 = jnp.float32

    def nrm(k, shape, scale):
        return jax.random.normal(k, shape, f32) * scale

    a0 = jax.random.uniform(ks[13], (DEPTH, LRU_WIDTH), f32, minval=0.9, maxval=0.999)
    return {
        "x": nrm(ks[0], (BATCH, SEQ, D_MODEL), 1.0),
        "meta_tokens": nrm(ks[1], (N_META, D_MODEL), 1.0),
        "norm1_g": 1.0 + nrm(ks[2], (DEPTH, D_MODEL), 0.02),
        "w_in": nrm(ks[3], (DEPTH, D_MODEL, IN_W), D_MODEL ** -0.5),
        "q_norm_g": 1.0 + nrm(ks[4], (DEPTH, HEAD_DIM), 0.02),
        "k_norm_g": 1.0 + nrm(ks[5], (DEPTH, HEAD_DIM), 0.02),
        "attn_sinks": nrm(ks[6], (DEPTH, N_Q_HEADS), 0.5),
        "w_o_attn": nrm(ks[7], (DEPTH, ATTN_W, D_MODEL), ATTN_W ** -0.5),
        "conv_w": nrm(ks[8], (DEPTH, CONV_W, LRU_WIDTH), CONV_W ** -0.5),
        "conv_b": nrm(ks[9], (DEPTH, LRU_WIDTH), 0.01),
        "lru_wa": nrm(ks[10], (DEPTH, LRU_BLOCKS, LRU_BLOCK_W, LRU_BLOCK_W), LRU_BLOCK_W ** -0.5),
        "lru_ba": nrm(ks[11], (DEPTH, LRU_WIDTH), 0.01),
        "lru_wi": nrm(ks[12], (DEPTH, LRU_BLOCKS, LRU_BLOCK_W, LRU_BLOCK_W), LRU_BLOCK_W ** -0.5),
        "lru_bi": nrm(ks[14], (DEPTH, LRU_WIDTH), 0.01),
        "lru_lambda": jnp.log(a0) - jnp.log1p(-a0),
        "w_o_lru": nrm(ks[15], (DEPTH, LRU_WIDTH, D_MODEL), LRU_WIDTH ** -0.5),
        "w_out": nrm(ks[16], (DEPTH, D_MODEL, D_MODEL), D_MODEL ** -0.5),
        "norm2_g": 1.0 + nrm(ks[17], (DEPTH, D_MODEL), 0.02),
        "w_up": nrm(ks[18], (DEPTH, D_MODEL, D_FF), D_MODEL ** -0.5),
        "w_down": nrm(ks[19], (DEPTH, D_FF, D_MODEL), D_FF ** -0.5),
    }


def reference(x, meta_tokens, norm1_g, w_in, q_norm_g, k_norm_g, attn_sinks, w_o_attn,
              conv_w, conv_b, lru_wa, lru_ba, lru_wi, lru_bi, lru_lambda, w_o_lru,
              w_out, norm2_g, w_up, w_down):
    B, S, _ = x.shape
    meta = jnp.broadcast_to(meta_tokens[None].astype(x.dtype), (B, N_META, D_MODEL))
    h = jnp.concatenate([meta, x], axis=1)
    T = h.shape[1]
    for l in range(DEPTH):
        xn = rmsnorm(h, norm1_g[l])
        z = xn @ w_in[l]
        q, k, v, lx, lg, ga, gl = jnp.split(z, IN_SPLITS, axis=-1)
        q = rmsnorm(q.reshape(B, T, N_Q_HEADS, HEAD_DIM), q_norm_g[l])
        k = rmsnorm(k.reshape(B, T, N_KV_HEADS, HEAD_DIM), k_norm_g[l])
        v = v.reshape(B, T, N_KV_HEADS, HEAD_DIM)
        attn = sliding_window_attention(q, k, v, attn_sinks[l]) @ w_o_attn[l]

        lc = causal_depthwise_conv(lx, conv_w[l], conv_b[l])
        lh = rg_lru(lc, lru_wa[l], lru_ba[l], lru_wi[l], lru_bi[l], lru_lambda[l])
        rec = (jax.nn.gelu(lg) * lh) @ w_o_lru[l]

        mixed = jax.nn.sigmoid(ga) * attn + jax.nn.sigmoid(gl) * rec
        h = h + mixed @ w_out[l]
        hn = rmsnorm(h, norm2_g[l])
        h = h + jnp.square(jax.nn.relu(hn @ w_up[l])) @ w_down[l]
    return h[:, N_META:]
```

```cpp
#include <hip/hip_runtime.h>
#include <hip/hip_cooperative_groups.h>
#include <cstdio>
#include <cstdint>
namespace cg = cooperative_groups;

#ifndef MK_MULTI
#define MK_MULTI 0
#endif

#ifndef PROBE_DUP
#define PROBE_DUP -1
#endif

#define LAS __attribute__((address_space(3)))
typedef unsigned short bf16_t;
typedef short bf16x8 __attribute__((ext_vector_type(8)));
typedef float f32x4 __attribute__((ext_vector_type(4)));
typedef float f32x2 __attribute__((ext_vector_type(2)));
typedef unsigned u32x4 __attribute__((ext_vector_type(4)));
typedef unsigned u32x2 __attribute__((ext_vector_type(2)));

constexpr int DM = 2048, NBATCH = 4, SEQ = 2048, MR = NBATCH * SEQ  , NMETA = 16, MPAD = 8448  ;
constexpr int INW = 10752, FF = 8192, KVW = 256;
constexpr float EPS = 1e-6f;
constexpr float LOG2E = 1.4426950408889634f;
constexpr int NTHREADS = 512, NWAVES = 8;
constexpr int LDS_BYTES = 147456;

constexpr size_t MiB = 1u << 20;
constexpr size_t WS_CTL = 0;
constexpr size_t WS_BAR = 65536, WS_BAR_BYTES = 65536;
constexpr size_t WS_R1 = 1 * MiB;
constexpr size_t WS_WTIN = WS_R1, WS_XN = WS_R1 + 42 * MiB;
constexpr size_t WS_WTUP = 272 * MiB, WS_WTDN = 304 * MiB;
constexpr size_t WS_WOA = 76 * MiB, WS_WOL = 84 * MiB, WS_WOUT = 92 * MiB, WS_WA = 100 * MiB, WS_WI = 101 * MiB;
constexpr size_t WS_Q = 102 * MiB;
constexpr size_t WS_K = 134 * MiB, WS_V = 134 * MiB + 4608 * 1024;
constexpr size_t WS_LX = 143 * MiB;
constexpr size_t WS_LG = 176 * MiB;
constexpr size_t WS_GA = 208 * MiB, WS_GL = 240 * MiB;
constexpr size_t WS_U = 143 * MiB;
#if PROBE_DUP == 3 || PROBE_DUP == 4
constexpr size_t WS_O = WS_R1, WS_REC = WS_R1 + 32 * MiB;
#else
constexpr size_t WS_O = WS_Q, WS_REC = WS_LG;
#endif
constexpr size_t WS_END = 336 * MiB;

typedef __bf16 bf16x2_t __attribute__((ext_vector_type(2)));
__device__ __forceinline__ unsigned cvt_pk_bf16(float lo, float hi) { const f32x2 v = {lo, hi}; const bf16x2_t b = __builtin_convertvector(v, bf16x2_t); return __builtin_bit_cast(unsigned, b); }
__device__ __forceinline__ float bf_lo(unsigned w) { return __uint_as_float(w << 16); }
__device__ __forceinline__ float bf_hi(unsigned w) { return __uint_as_float(w & 0xffff0000u); }
__device__ __forceinline__ float bf2f(bf16_t u) { return __uint_as_float((unsigned)u << 16); }
__device__ __forceinline__ float fast_sigmoid(float x) { return __builtin_amdgcn_rcpf(1.0f + __builtin_amdgcn_exp2f(-x * LOG2E)); }
__device__ __forceinline__ float gelu_tanh(float x) { const float y = 0.7978845608028654f * (x + 0.044715f * x * x * x); return x * __builtin_amdgcn_rcpf(1.0f + __builtin_amdgcn_exp2f(-2.0f * LOG2E * y)); }
#define LDS_WAIT() asm volatile("s_waitcnt lgkmcnt(0)" ::: "memory")
#define WG_BAR() do { asm volatile("s_waitcnt lgkmcnt(0)" ::: "memory"); __builtin_amdgcn_s_barrier(); asm volatile("" ::: "memory"); } while (0)

namespace pg8 {
constexpr int BM = 256, BK = 64, HALF = 128, HTB = HALF * BK * 2, STAGE_BYTES = 8 * HTB, NXCD = 8, WGM = 8;
__host__ __device__ __forceinline__ int lds_byte(int r, int c) { const int st = (r >> 4) * 2 + (c >> 5), rr = r & 15, cc = c & 31, ob = rr * 64 + cc * 2; return st * 1024 + (ob ^ (((ob >> 9) & 1) << 5)); }
__host__ __device__ __forceinline__ void stage_rc(int b, int& R, int& C) { const int st = b / 1024, sb = b % 1024, swz = sb ^ (((sb >> 9) & 1) << 5); R = (st >> 1) * 16 + swz / 64; C = (st & 1) * 32 + (swz % 64) / 2; }
__host__ __device__ __forceinline__ int perm32(int rho) { const int n = rho >> 4, i = rho & 15; return 8 * (i >> 2) + 4 * n + (i & 3); }

struct Unit { int pm, pn, sub; };

__device__ __forceinline__ void tile_of(int wgid, int nM, int nN, Unit& u) {
    const int nwg = nM * nN;
    { const int q = nwg / NXCD, r = nwg % NXCD, xcd = wgid % NXCD, off = wgid / NXCD; wgid = (xcd < r ? xcd * (q + 1) : r * (q + 1) + (xcd - r) * q) + off; }
    const int nig = WGM * nN, gid = wgid / nig, fm = gid * WGM, gsz = (nM - fm) < WGM ? (nM - fm) : WGM;
    u.pm = fm + ((wgid % nig) % gsz); u.pn = (wgid % nig) / gsz; u.sub = 0;
}

template <class Epi, class Sched, bool SPLITK = false>
__device__ __forceinline__ void gemm_phase(LAS unsigned char* lds, const int K, const Sched& S, const Epi& E) {
    const int tid = threadIdx.x, wid = __builtin_amdgcn_readfirstlane(tid >> 6), lane = tid & 63, wr = wid >> 2, wc = wid & 3, fr = lane & 15, fq = lane >> 4;
    const int nt = K / BK, nth = nt / 2, ld = SPLITK ? K / 2 : K;
    unsigned voffA[2], voffB[2];
#pragma unroll
    for (int i = 0; i < 2; ++i) { int R, C; stage_rc(tid * 16 + i * 8192, R, C); const int Rb = Epi::PERM ? ((R & ~31) + perm32(R & 31)) : R;
        voffA[i] = (unsigned)(R * ld + C) * 2u; voffB[i] = (unsigned)(Rb * ld + C) * 2u; }
    const size_t kstep = (size_t)(BK * 2);
    const size_t hstep = (size_t)HALF * ld * 2;
    const unsigned ldsw = (unsigned)wid * 1024u;
    const int aoff = lds_byte(wr * 64 + fr, fq * 8), boff = lds_byte(wc * 32 + fr, fq * 8);
#define PG8_SA(b, h) (((b) * 2 + (h)) * HTB)
#define PG8_SB(b, h) ((4 + (b) * 2 + (h)) * HTB)
#define PG8_STAGE(bufoff, gbase, voff) do { _Pragma("unroll") for (int _i = 0; _i < 2; ++_i) \
        __builtin_amdgcn_global_load_lds((const unsigned*)((const char*)(gbase) + (voff)[_i]), (LAS unsigned*)(lds + (bufoff) + ldsw + _i * 8192), 16, 0, 0); } while (0)
#define PG8_LDA(dst, b, h) do { _Pragma("unroll") for (int m = 0; m < 4; ++m) _Pragma("unroll") for (int k = 0; k < 2; ++k) dst[m][k] = *(const LAS bf16x8*)(lds + PG8_SA(b, h) + aoff + m * 2048 + k * 1024); } while (0)
#define PG8_LDB(dst, b, h) do { _Pragma("unroll") for (int n = 0; n < 2; ++n) _Pragma("unroll") for (int k = 0; k < 2; ++k) dst[n][k] = *(const LAS bf16x8*)(lds + PG8_SB(b, h) + boff + n * 2048 + k * 1024); } while (0)
#define PG8_MMA(ai, bj, At, Bt) do { __builtin_amdgcn_s_setprio(1); _Pragma("unroll") for (int m = 0; m < 4; ++m) _Pragma("unroll") for (int n = 0; n < 2; ++n) _Pragma("unroll") for (int k = 0; k < 2; ++k) \
        acc[ai][bj][m][n] = __builtin_amdgcn_mfma_f32_16x16x32_bf16(Bt[n][k], At[m][k], acc[ai][bj][m][n], 0, 0, 0); __builtin_amdgcn_s_setprio(0); } while (0)
#define PG8_WAIT_V(n) asm volatile("s_waitcnt vmcnt(" #n ")" ::: "memory")
#define PG8_WAIT_L(n) asm volatile("s_waitcnt lgkmcnt(" #n ")" ::: "memory")
#define PG8_BAR __builtin_amdgcn_s_barrier()
#define PG8_SCHED __builtin_amdgcn_sched_barrier(0)
    Unit cur, nxt; int ui = 0;
    if (!S.next(0, cur)) return;
    f32x4 acc[2][2][4][2];
    E.init(acc, cur, wr, wc, fr, fq);
    bf16x8 At[4][2], B0[2][2], B1[2][2];
    const char* cA = S.a_base(cur); const char* cB = S.b_base(cur);
    const char* cA2 = cA; const char* cB2 = cB;
    if constexpr (SPLITK) { cA2 = S.a_base2(cur); cB2 = S.b_base2(cur); }
#define PG8_KTA(j) ((SPLITK && (j) >= nth) ? cA2 + (size_t)((j) - nth) * kstep : cA + (size_t)(j) * kstep)
#define PG8_KTB(j) ((SPLITK && (j) >= nth) ? cB2 + (size_t)((j) - nth) * kstep : cB + (size_t)(j) * kstep)
    PG8_STAGE(PG8_SB(0, 0), cB, voffB); PG8_STAGE(PG8_SB(0, 1), cB + hstep, voffB); PG8_STAGE(PG8_SA(0, 0), cA, voffA); PG8_STAGE(PG8_SA(0, 1), cA + hstep, voffA);
    if (wr == 1) PG8_BAR;
    PG8_WAIT_V(2); PG8_BAR;
    PG8_STAGE(PG8_SB(1, 0), cB + kstep, voffB); PG8_STAGE(PG8_SA(1, 0), cA + kstep, voffA); PG8_STAGE(PG8_SB(1, 1), cB + hstep + kstep, voffB);
    PG8_WAIT_V(6); PG8_BAR;
    for (;;) {
        const bool has_next = S.next(ui + 1, nxt);
        const char* nA = has_next ? S.a_base(nxt) : cA; const char* nB = has_next ? S.b_base(nxt) : cB;
        for (int t = 0; t < nt; t += 2) {
            const bool last = (t == nt - 2);
            const char* a1 = PG8_KTA(t + 1);
            const char* a2 = last ? nA : PG8_KTA(t + 2); const char* b2 = last ? nB : PG8_KTB(t + 2);
            const char* a3 = last ? nA + kstep : PG8_KTA(t + 3); const char* b3 = last ? nB + kstep : PG8_KTB(t + 3);
            if constexpr (SPLITK) { if (t == nth) E.mid(acc, cur, wr, wc, fr, fq); }
            PG8_LDB(B0, 0, 0); PG8_LDB(B1, 0, 1); PG8_SCHED; PG8_LDA(At, 0, 0); PG8_STAGE(PG8_SA(1, 1), a1 + hstep, voffA);
            PG8_WAIT_V(8); PG8_WAIT_L(0); PG8_BAR; PG8_MMA(0, 0, At, B0); PG8_MMA(0, 1, At, B1); PG8_BAR; PG8_SCHED;
            PG8_LDA(At, 0, 1); PG8_STAGE(PG8_SB(0, 0), b2, voffB); PG8_STAGE(PG8_SB(0, 1), b2 + hstep, voffB); PG8_STAGE(PG8_SA(0, 0), a2, voffA);
            PG8_WAIT_V(8); PG8_WAIT_L(0); PG8_BAR; PG8_MMA(1, 0, At, B0); PG8_MMA(1, 1, At, B1); PG8_BAR; PG8_SCHED;
            PG8_LDB(B0, 1, 0); PG8_LDB(B1, 1, 1); PG8_SCHED; PG8_LDA(At, 1, 0); PG8_STAGE(PG8_SA(0, 1), a2 + hstep, voffA);
            PG8_WAIT_V(8); PG8_WAIT_L(0); PG8_BAR; PG8_MMA(0, 0, At, B0); PG8_MMA(0, 1, At, B1); PG8_BAR; PG8_SCHED;
            PG8_LDA(At, 1, 1); PG8_STAGE(PG8_SB(1, 0), b3, voffB); PG8_STAGE(PG8_SB(1, 1), b3 + hstep, voffB); PG8_STAGE(PG8_SA(1, 0), a3, voffA);
            PG8_WAIT_V(8); PG8_WAIT_L(0); PG8_BAR; PG8_MMA(1, 0, At, B0); PG8_MMA(1, 1, At, B1); PG8_BAR; PG8_SCHED;
        }
        if (wr == 0) PG8_BAR;
        E(acc, cur, wr, wc, fr, fq);
        if (!has_next) break;
        E.init(acc, nxt, wr, wc, fr, fq);
        cur = nxt; cA = nA; cB = nB; ++ui;
        if constexpr (SPLITK) { cA2 = S.a_base2(cur); cB2 = S.b_base2(cur); }
        if (wr == 1) PG8_BAR;
    }
    PG8_WAIT_V(0);
    PG8_BAR;
#undef PG8_KTA
#undef PG8_KTB
#undef PG8_SA
#undef PG8_SB
#undef PG8_STAGE
#undef PG8_LDA
#undef PG8_LDB
#undef PG8_MMA
#undef PG8_WAIT_V
#undef PG8_WAIT_L
#undef PG8_BAR
#undef PG8_SCHED
}
}
using pg8::Unit;

struct SchedIn {
    const char* A; const char* B; int G, c;
    __device__ __forceinline__ bool next(int i, Unit& u) const {
        const int L = i * G + c; constexpr int NREG = 32 * 42;
        if (L < NREG) { pg8::tile_of(L, 32, 42, u); return true; }
        if (L < NREG + 10) { u.pm = 32; u.pn = 8 + (L - NREG); u.sub = 0; return true; }
        return false;
    }
    __device__ __forceinline__ const char* a_base(const Unit& u) const { return A + (size_t)u.pm * (256u * DM * 2u); }
    __device__ __forceinline__ const char* b_base(const Unit& u) const { return B + (size_t)u.pn * (256u * DM * 2u); }
};
struct SchedMix {
    const char* A0; const char* A1; const char* B0; const char* B1; int G, c;
    __device__ __forceinline__ bool next(int i, Unit& u) const {
        const int L = i * G + c; if (L >= 32 * 8) return false;
        pg8::tile_of(L, 32, 8, u); return true;
    }
    __device__ __forceinline__ const char* a_base(const Unit& u) const { return A0 + (size_t)u.pm * (256u * DM * 2u); }
    __device__ __forceinline__ const char* b_base(const Unit& u) const { return B0 + (size_t)u.pn * (256u * DM * 2u); }
    __device__ __forceinline__ const char* a_base2(const Unit& u) const { return A1 + (size_t)u.pm * (256u * DM * 2u); }
    __device__ __forceinline__ const char* b_base2(const Unit& u) const { return B1 + (size_t)u.pn * (256u * DM * 2u); }
};
struct SchedPlain {
    const char* A; const char* B; int nM, nN, K, G, c;
    __device__ __forceinline__ bool next(int i, Unit& u) const {
        const int L = i * G + c; if (L >= nM * nN) return false;
        pg8::tile_of(L, nM, nN, u); return true;
    }
    __device__ __forceinline__ const char* a_base(const Unit& u) const { return A + (size_t)u.pm * 256u * (size_t)K * 2u; }
    __device__ __forceinline__ const char* b_base(const Unit& u) const { return B + (size_t)u.pn * 256u * (size_t)K * 2u; }
};

__device__ __forceinline__ void acc_zero(f32x4 (&acc)[2][2][4][2]) {
#pragma unroll
    for (int a = 0; a < 2; ++a)
#pragma unroll
        for (int b = 0; b < 2; ++b)
#pragma unroll
            for (int m = 0; m < 4; ++m)
#pragma unroll
                for (int n = 0; n < 2; ++n) acc[a][b][m][n] = (f32x4){0.f, 0.f, 0.f, 0.f};
}
#define EPI_ZERO_INIT __device__ __forceinline__ void init(f32x4 (&acc)[2][2][4][2], const Unit&, int, int, int, int) const { acc_zero(acc); }
__device__ __forceinline__ void acc_load_f32(f32x4 (&acc)[2][2][4][2], const float* src, const Unit& u, int wr, int wc, int fr, int fq) {
    const int row0 = u.pm * 256 + wr * 64 + fr, col0 = u.pn * 256 + wc * 32 + 4 * fq;
#pragma unroll
    for (int ai = 0; ai < 2; ++ai)
#pragma unroll
        for (int m = 0; m < 4; ++m) { const size_t off = (size_t)(row0 + ai * 128 + m * 16) * DM + col0;
#pragma unroll
            for (int bj = 0; bj < 2; ++bj)
#pragma unroll
                for (int n = 0; n < 2; ++n) acc[ai][bj][m][n] = __builtin_nontemporal_load((const f32x4*)(src + off + bj * 128 + n * 16)); }
}
struct EpiIn {
    static constexpr bool PERM = true;
    bf16_t *Q, *Kb, *Vb, *LX, *LG, *GA, *GL;
    EPI_ZERO_INIT
    __device__ __forceinline__ void operator()(const f32x4 (&acc)[2][2][4][2], const Unit& u, int wr, int wc, int fr, int fq) const {
        const int pn = u.pn; int mode = 0, ldc = DM, colt; bf16_t* base;
        if (pn < 8) { base = Q; colt = pn * 256; }
        else if (pn == 8) { base = Kb; ldc = KVW; colt = 0; }
        else if (pn == 9) { base = Vb; ldc = KVW; colt = 0; }
        else if (pn < 18) { base = LX; colt = (pn - 10) * 256; }
        else if (pn < 26) { base = LG; colt = (pn - 18) * 256; mode = 1; }
        else {
            const int row0g = u.pm * 256 + wr * 64 + fr, ch0 = (pn - 26) * 128 + wc * 32 + 8 * fq;
#pragma unroll
            for (int ai = 0; ai < 2; ++ai)
#pragma unroll
                for (int m = 0; m < 4; ++m) { const size_t off = (size_t)(row0g + ai * 128 + m * 16) * DM + ch0;
                    float sr[8], sl[8];
#pragma unroll
                    for (int e = 0; e < 4; ++e) { const float a0 = fast_sigmoid(acc[ai][0][m][0][e]), a1 = fast_sigmoid(acc[ai][0][m][1][e]); sl[e] = fast_sigmoid(acc[ai][1][m][0][e]); sl[4 + e] = fast_sigmoid(acc[ai][1][m][1][e]);
                        sr[e] = a0 * __builtin_amdgcn_rcpf(fmaxf(sl[e], 1e-30f)); sr[4 + e] = a1 * __builtin_amdgcn_rcpf(fmaxf(sl[4 + e], 1e-30f)); }
                    u32x4 wr4, wl4;
                    wr4.x = cvt_pk_bf16(sr[0], sr[1]); wr4.y = cvt_pk_bf16(sr[2], sr[3]); wr4.z = cvt_pk_bf16(sr[4], sr[5]); wr4.w = cvt_pk_bf16(sr[6], sr[7]);
                    wl4.x = cvt_pk_bf16(sl[0], sl[1]); wl4.y = cvt_pk_bf16(sl[2], sl[3]); wl4.z = cvt_pk_bf16(sl[4], sl[5]); wl4.w = cvt_pk_bf16(sl[6], sl[7]);
                    __builtin_nontemporal_store(wr4, (u32x4*)(GA + off)); __builtin_nontemporal_store(wl4, (u32x4*)(GL + off)); }
            return;
        }
        const int row0 = u.pm * 256 + wr * 64 + fr, col0 = colt + wc * 32 + 8 * fq;
        const bool islx = (pn >= 10 && pn < 18);
#pragma unroll
        for (int ai = 0; ai < 2; ++ai)
#pragma unroll
            for (int m = 0; m < 4; ++m) { const int row = row0 + ai * 128 + m * 16; int orow = row;
                if (islx) orow = (row < MR) ? row + 16 * ((row >> 11) + 1) : row - MR;
                bf16_t* rowp = base + (size_t)orow * ldc + col0;
                const bool metarow = islx && row >= MR; if (metarow && row >= MR + NMETA) continue;
#pragma unroll
                for (int bj = 0; bj < 2; ++bj) { f32x4 v0 = acc[ai][bj][m][0], v1 = acc[ai][bj][m][1];
                    if (mode == 1) {
#pragma unroll
                        for (int e = 0; e < 4; ++e) { v0[e] = gelu_tanh(v0[e]); v1[e] = gelu_tanh(v1[e]); } }
                    else if (mode == 2) {
#pragma unroll
                        for (int e = 0; e < 4; ++e) { v0[e] = fast_sigmoid(v0[e]); v1[e] = fast_sigmoid(v1[e]); } }
                    u32x4 w; w.x = cvt_pk_bf16(v0[0], v0[1]); w.y = cvt_pk_bf16(v0[2], v0[3]); w.z = cvt_pk_bf16(v1[0], v1[1]); w.w = cvt_pk_bf16(v1[2], v1[3]);
                    *(u32x4*)(rowp + bj * 128) = w;
                    if (metarow) { *(u32x4*)(rowp + (size_t)2064 * DM + bj * 128) = w; *(u32x4*)(rowp + (size_t)(2 * 2064) * DM + bj * 128) = w; *(u32x4*)(rowp + (size_t)(3 * 2064) * DM + bj * 128) = w; } } }
    }
};
struct EpiMix {
    static constexpr bool PERM = true;
    const bf16_t *GA, *GL; bf16_t* MIX;
    EPI_ZERO_INIT
    __device__ __forceinline__ void mid(f32x4 (&acc)[2][2][4][2], const Unit& u, int wr, int wc, int fr, int fq) const {
        const int row0 = u.pm * 256 + wr * 64 + fr, col0 = u.pn * 256 + wc * 32 + 8 * fq;
#pragma unroll
        for (int ai = 0; ai < 2; ++ai)
#pragma unroll
            for (int m = 0; m < 4; ++m) { const size_t off = (size_t)(row0 + ai * 128 + m * 16) * DM + col0;
#pragma unroll
                for (int bj = 0; bj < 2; ++bj) { const u32x4 aw = __builtin_nontemporal_load((const u32x4*)(GA + off + bj * 128));
                    const float ra[8] = {bf_lo(aw.x), bf_hi(aw.x), bf_lo(aw.y), bf_hi(aw.y), bf_lo(aw.z), bf_hi(aw.z), bf_lo(aw.w), bf_hi(aw.w)};
#pragma unroll
                    for (int e = 0; e < 4; ++e) { acc[ai][bj][m][0][e] *= ra[e]; acc[ai][bj][m][1][e] *= ra[4 + e]; } } }
    }
    __device__ __forceinline__ void operator()(const f32x4 (&acc)[2][2][4][2], const Unit& u, int wr, int wc, int fr, int fq) const {
        const int row0 = u.pm * 256 + wr * 64 + fr, col0 = u.pn * 256 + wc * 32 + 8 * fq;
#pragma unroll
        for (int ai = 0; ai < 2; ++ai)
#pragma unroll
            for (int m = 0; m < 4; ++m) { const size_t off = (size_t)(row0 + ai * 128 + m * 16) * DM + col0;
#pragma unroll
                for (int bj = 0; bj < 2; ++bj) { const f32x4 a0 = acc[ai][bj][m][0], a1 = acc[ai][bj][m][1];
                    const u32x4 gw = __builtin_nontemporal_load((const u32x4*)(GL + off + bj * 128));
                    u32x4 w; w.x = cvt_pk_bf16(a0[0] * bf_lo(gw.x), a0[1] * bf_hi(gw.x)); w.y = cvt_pk_bf16(a0[2] * bf_lo(gw.y), a0[3] * bf_hi(gw.y));
                    w.z = cvt_pk_bf16(a1[0] * bf_lo(gw.z), a1[1] * bf_hi(gw.z)); w.w = cvt_pk_bf16(a1[2] * bf_lo(gw.w), a1[3] * bf_hi(gw.w));
                    *(u32x4*)(MIX + off + bj * 128) = w; } }
    }
};
struct EpiRes {
    static constexpr bool PERM = false;
    const float* x; const float* g2; float* out; bf16_t* HG; float* rowss; int noatom;
    __device__ __forceinline__ void init(f32x4 (&acc)[2][2][4][2], const Unit& u, int wr, int wc, int fr, int fq) const { acc_load_f32(acc, x, u, wr, wc, fr, fq); }
    __device__ __forceinline__ void operator()(const f32x4 (&acc)[2][2][4][2], const Unit& u, int wr, int wc, int fr, int fq) const {
        const int row0 = u.pm * 256 + wr * 64 + fr, col0 = u.pn * 256 + wc * 32 + 4 * fq;
        f32x4 gv[2][2];
#pragma unroll
        for (int bj = 0; bj < 2; ++bj)
#pragma unroll
            for (int n = 0; n < 2; ++n) gv[bj][n] = *(const f32x4*)(g2 + col0 + bj * 128 + n * 16);
#pragma unroll
        for (int ai = 0; ai < 2; ++ai)
#pragma unroll
            for (int m = 0; m < 4; ++m) { const int row = row0 + ai * 128 + m * 16; const size_t off = (size_t)row * DM + col0; float ss = 0.f;
#pragma unroll
                for (int bj = 0; bj < 2; ++bj)
#pragma unroll
                    for (int n = 0; n < 2; ++n) { const f32x4 h = acc[ai][bj][m][n];
                        __builtin_nontemporal_store(h, (f32x4*)(out + off + bj * 128 + n * 16));
                        ss += (h[0] * h[0] + h[1] * h[1]) + (h[2] * h[2] + h[3] * h[3]);
                        const f32x4 hg = h * gv[bj][n]; u32x2 w; w.x = cvt_pk_bf16(hg[0], hg[1]); w.y = cvt_pk_bf16(hg[2], hg[3]);
                        *(u32x2*)(HG + off + bj * 128 + n * 16) = w; }
                ss += __shfl_xor(ss, 16); ss += __shfl_xor(ss, 32);
                if (fq == 0 && !noatom) atomicAdd(rowss + row, ss); }
    }
};
struct EpiUp {
    static constexpr bool PERM = true;
    const float* rowss; bf16_t* U;
    EPI_ZERO_INIT
    __device__ __forceinline__ void operator()(const f32x4 (&acc)[2][2][4][2], const Unit& u, int wr, int wc, int fr, int fq) const {
        const int row0 = u.pm * 256 + wr * 64 + fr, col0 = u.pn * 256 + wc * 32 + 8 * fq;
#pragma unroll
        for (int ai = 0; ai < 2; ++ai)
#pragma unroll
            for (int m = 0; m < 4; ++m) { const int row = row0 + ai * 128 + m * 16; const float rs = __builtin_amdgcn_rsqf(rowss[row] * (1.0f / DM) + EPS);
                bf16_t* rowp = U + (size_t)row * FF + col0;
#pragma unroll
                for (int bj = 0; bj < 2; ++bj) { f32x4 v0 = acc[ai][bj][m][0] * rs, v1 = acc[ai][bj][m][1] * rs;
#pragma unroll
                    for (int e = 0; e < 4; ++e) { const float a = fmaxf(v0[e], 0.f), b = fmaxf(v1[e], 0.f); v0[e] = a * a; v1[e] = b * b; }
                    u32x4 w; w.x = cvt_pk_bf16(v0[0], v0[1]); w.y = cvt_pk_bf16(v0[2], v0[3]); w.z = cvt_pk_bf16(v1[0], v1[1]); w.w = cvt_pk_bf16(v1[2], v1[3]);
                    *(u32x4*)(rowp + bj * 128) = w; } }
    }
};
struct EpiDown {
    static constexpr bool PERM = false;
    float* out; int nostore;
    __device__ __forceinline__ void init(f32x4 (&acc)[2][2][4][2], const Unit& u, int wr, int wc, int fr, int fq) const { acc_load_f32(acc, out, u, wr, wc, fr, fq); }
    __device__ __forceinline__ void operator()(const f32x4 (&acc)[2][2][4][2], const Unit& u, int wr, int wc, int fr, int fq) const {
        const int row0 = u.pm * 256 + wr * 64 + fr, col0 = u.pn * 256 + wc * 32 + 4 * fq;
#pragma unroll
        for (int ai = 0; ai < 2; ++ai)
#pragma unroll
            for (int m = 0; m < 4; ++m) { const size_t off = (size_t)(row0 + ai * 128 + m * 16) * DM + col0;
#pragma unroll
                for (int bj = 0; bj < 2; ++bj)
#pragma unroll
                    for (int n = 0; n < 2; ++n) { float* p = out + off + bj * 128 + n * 16; if (!nostore) __builtin_nontemporal_store(acc[ai][bj][m][n], (f32x4*)p); } }
    }
};

struct Args {
    const float *x, *meta, *norm1_g, *w_in, *q_norm_g, *k_norm_g, *sinks, *w_o_attn, *conv_w, *conv_b, *lru_wa, *lru_ba, *lru_wi, *lru_bi, *lru_lambda, *w_o_lru, *w_out, *norm2_g, *w_up, *w_down;
    float* out; unsigned char* ws; int ph_lo, ph_hi, flags, pad;
};

__device__ __forceinline__ float wave_sum(float v) {
#pragma unroll
    for (int o = 1; o < 64; o <<= 1) v += __shfl_xor(v, o);
    return v;
}
__device__ __forceinline__ void transpose_load(f32x4 (&v)[16], const float* __restrict__ W, int N, int item, int lane) {
    const int nblk = N >> 6, kb = item / nblk, nb = item - kb * nblk, k0 = kb * 64, n0 = nb * 64;
    const int lr = lane >> 4, lc = (lane & 15) * 4;
    const unsigned off0 = (unsigned)((k0 + lr) * N + n0 + lc), rstep = (unsigned)(4 * N);
#pragma unroll
    for (int i = 0; i < 16; ++i) v[i] = __builtin_nontemporal_load((const f32x4*)(W + (off0 + (unsigned)i * rstep)));
}
template <bool NT = false> __device__ __forceinline__ void transpose_store(const f32x4 (&v)[16], int K, int N, bf16_t* __restrict__ WT, int row_off, LAS float* scr, int item, int lane) {
    const int nblk = N >> 6, kb = item / nblk, nb = item - kb * nblk, k0 = kb * 64, n0 = nb * 64;
    const int lr = lane >> 4, lc = (lane & 15) * 4;
#pragma unroll
    for (int i = 0; i < 16; ++i) { LAS float* s = scr + (4 * i + lr) * 65 + lc; s[0] = v[i][0]; s[1] = v[i][1]; s[2] = v[i][2]; s[3] = v[i][3]; }
    LDS_WAIT(); asm volatile("" ::: "memory");
    const int c = lane & 7, ns = lane >> 3;
    bf16_t* wp = WT + (size_t)(row_off + n0 + ns) * K + k0 + 8 * c; const size_t wstep = (size_t)8 * K;
#pragma unroll
    for (int j = 0; j < 8; ++j) { const LAS float* s = scr + (8 * c) * 65 + ns + 8 * j;
        u32x4 o; o.x = cvt_pk_bf16(s[0 * 65], s[1 * 65]); o.y = cvt_pk_bf16(s[2 * 65], s[3 * 65]); o.z = cvt_pk_bf16(s[4 * 65], s[5 * 65]); o.w = cvt_pk_bf16(s[6 * 65], s[7 * 65]);
        if (NT) __builtin_nontemporal_store(o, (u32x4*)wp); else *(u32x4*)wp = o;
        wp += wstep; asm volatile("" : "+v"(wp)); }
    LDS_WAIT(); asm volatile("" ::: "memory");
}
__device__ __forceinline__ void transpose_item(const float* __restrict__ W, int K, int N, bf16_t* __restrict__ WT, int row_off, LAS float* scr, int item, int lane) {
    f32x4 v[16]; transpose_load(v, W, N, item, lane); transpose_store(v, K, N, WT, row_off, scr, item, lane);
}
__device__ __forceinline__ void rms_row_to_bf16(const float* xrow, const float* g, bf16_t* orow, int lane) {
    const f32x4* xr = (const f32x4*)xrow + lane; const f32x4* gr = (const f32x4*)g + lane;
    f32x4 v[8], gv[8]; float s = 0.f;
#pragma unroll
    for (int j = 0; j < 8; ++j) { v[j] = xr[64 * j]; gv[j] = gr[64 * j]; }
#pragma unroll
    for (int j = 0; j < 8; ++j) s += (v[j][0] * v[j][0] + v[j][1] * v[j][1]) + (v[j][2] * v[j][2] + v[j][3] * v[j][3]);
    const float rs = 1.0f / sqrtf(wave_sum(s) * (1.0f / DM) + EPS);
    u32x2* o8 = (u32x2*)orow + lane;
#pragma unroll
    for (int j = 0; j < 8; ++j) { const f32x4 gg = gv[j]; u32x2 w; w.x = cvt_pk_bf16(v[j][0] * rs * gg[0], v[j][1] * rs * gg[1]); w.y = cvt_pk_bf16(v[j][2] * rs * gg[2], v[j][3] * rs * gg[3]); o8[64 * j] = w; }
}


#define XB_TMO      128
#define XB_XCNT(j)  (256  + 64 * (j))
#define XB_XSUB(j)  (1280 + 64 * (j))
#define XB_XGEN(j)  (2304 + 64 * (j))
#define XB_TOP      3328
#define XB_TOPGEN   3392
#define XCD_BAR_WORDS 3456
#define XB_SPIN_CAP (1u << 18)
__device__ __forceinline__ unsigned xb_ld(unsigned* p)              { return __hip_atomic_load(p, __ATOMIC_RELAXED, __HIP_MEMORY_SCOPE_AGENT); }
__device__ __forceinline__ unsigned xb_add(unsigned* p, unsigned v) { return __hip_atomic_fetch_add(p, v, __ATOMIC_RELAXED, __HIP_MEMORY_SCOPE_AGENT); }
__device__ __forceinline__ unsigned xb_xcc_id() { return (unsigned)__builtin_amdgcn_s_getreg((3 << 11) | 20) & 0xFu; }
#define XB_SPIN(cond, bar) do { unsigned _sp = 0; while (cond) { __builtin_amdgcn_s_sleep(1); \
    if ((++_sp & 255u) == 0u) { if (xb_ld(&(bar)[XB_TMO])) break; if (_sp > XB_SPIN_CAP) { atomicAdd(&(bar)[XB_TMO], 1u); break; } } } } while (0)
struct XcdBarrier { unsigned* bar; unsigned x; volatile LAS unsigned* st; };
__device__ __forceinline__ XcdBarrier xcd_barrier_post(unsigned* bar, volatile LAS unsigned* st) {
    XcdBarrier b; b.bar = bar; b.x = xb_xcc_id(); b.st = st;
    if (threadIdx.x == 0) (void)xb_add(&bar[XB_XCNT(b.x)], 1u);
    return b;
}
__device__ __forceinline__ void xcd_barrier_complete(unsigned* bar, unsigned x, unsigned& nloc, unsigned& nx) {
    const unsigned G = gridDim.x * gridDim.y * gridDim.z;
    unsigned sum, cnt, mine, sp = 0u;
    for (;;) {
        sum = 0u; cnt = 0u; mine = 0u;
#pragma unroll
        for (unsigned j = 0; j < 16; ++j) { const unsigned c = xb_ld(&bar[XB_XCNT(j)]); sum += c; cnt += (c > 0u) ? 1u : 0u; mine = (j == x) ? c : mine; }
        if (sum == G) break;
        __builtin_amdgcn_s_sleep(1);
        if ((++sp & 255u) == 0u) { if (xb_ld(&bar[XB_TMO])) break; if (sp > XB_SPIN_CAP) { atomicAdd(&bar[XB_TMO], 1u); break; } }
    }
    nloc = mine > 0u ? mine : 1u; nx = cnt > 0u ? cnt : 1u;
}
__device__ __forceinline__ void xcd_barrier(const XcdBarrier& b) {
    asm volatile("s_waitcnt vmcnt(0)" ::: "memory");
    __syncthreads();
    if (threadIdx.x == 0) {
        unsigned* bar = b.bar;
        __builtin_amdgcn_s_waitcnt(0);
        unsigned nloc = b.st[0], nx = b.st[1];
        if (nloc == 0u) { xcd_barrier_complete(bar, b.x, nloc, nx); b.st[0] = nloc; b.st[1] = nx; }
        const unsigned old = xb_add(&bar[XB_XSUB(b.x)], 1u);
        const unsigned gen = old / nloc;
        if (old + 1u == (gen + 1u) * nloc) {
            __builtin_amdgcn_fence(__ATOMIC_RELEASE, "agent");
            asm volatile("s_waitcnt vmcnt(0)" ::: "memory");
            const unsigned og = xb_add(&bar[XB_TOP], 1u);
            const unsigned tg = og / nx;
            if (og + 1u == (tg + 1u) * nx) xb_add(&bar[XB_TOPGEN], 1u);
            else XB_SPIN(xb_ld(&bar[XB_TOPGEN]) == tg, bar);
            __builtin_amdgcn_fence(__ATOMIC_ACQUIRE, "agent");
            xb_add(&bar[XB_XGEN(b.x)], 1u);
            asm volatile("s_waitcnt vmcnt(0)" ::: "memory");
        } else {
            XB_SPIN(xb_ld(&bar[XB_XGEN(b.x)]) == gen, bar);
            __builtin_amdgcn_fence(__ATOMIC_ACQUIRE, "agent");
            asm volatile("s_waitcnt vmcnt(0)" ::: "memory");
        }
    }
    __syncthreads();
}

__global__ void __launch_bounds__(NTHREADS, 2) fwd_kernel(Args a) {
    extern __shared__ __attribute__((aligned(16))) unsigned char lds_raw[];
    LAS unsigned char* lds = (LAS unsigned char*)lds_raw;
    const int tid = threadIdx.x, lane = tid & 63, wave = __builtin_amdgcn_readfirstlane(tid >> 6);
    const int G = gridDim.x, bid = blockIdx.x;
    unsigned char* ws = a.ws;
    float* rowss = (float*)(ws + WS_CTL);
    bf16_t* Wt_in = (bf16_t*)(ws + WS_WTIN); bf16_t* XN = (bf16_t*)(ws + WS_XN);
    bf16_t* Wt_up = (bf16_t*)(ws + WS_WTUP); bf16_t* Wt_dn = (bf16_t*)(ws + WS_WTDN);
    bf16_t* Wt_oa = (bf16_t*)(ws + WS_WOA); bf16_t* Wt_ol = (bf16_t*)(ws + WS_WOL); bf16_t* Wt_out = (bf16_t*)(ws + WS_WOUT);
    bf16_t* Wt_a = (bf16_t*)(ws + WS_WA); bf16_t* Wt_i = (bf16_t*)(ws + WS_WI);
    bf16_t* Qb = (bf16_t*)(ws + WS_Q); bf16_t* Kb = (bf16_t*)(ws + WS_K); bf16_t* Vb = (bf16_t*)(ws + WS_V);
    bf16_t* LX = (bf16_t*)(ws + WS_LX); bf16_t* LG = (bf16_t*)(ws + WS_LG); bf16_t* GA = (bf16_t*)(ws + WS_GA); bf16_t* GL = (bf16_t*)(ws + WS_GL);
    bf16_t* MIX = LX; bf16_t* HG = Qb; bf16_t* U = (bf16_t*)(ws + WS_U); bf16_t* Ob = (bf16_t*)(ws + WS_O); bf16_t* REC = (bf16_t*)(ws + WS_REC);
    const int lo = a.ph_lo, hi = a.ph_hi;
#define IN(k) (lo <= (k) && (k) < hi)
    volatile LAS unsigned* bst = (volatile LAS unsigned*)(lds + LDS_BYTES - 16);
    if (tid < 4) bst[tid] = 0u;
    __syncthreads();
    const XcdBarrier xbar = xcd_barrier_post((unsigned*)(ws + WS_BAR) + (a.flags >> 8) * XCD_BAR_WORDS, bst);
#define SEAM(k) do { if (IN(k) && IN((k) + 1)) { xcd_barrier(xbar); } } while (0)
    if (a.ph_lo < 0) cg::this_grid().sync();

    if (IN(0)) {
        LAS float* scr = (LAS float*)(lds + wave * 16640);
        const int gw = bid * NWAVES + wave, NGW = G * NWAVES;
        constexpr int I_IN = 32 * 168, I_SQ = 32 * 32, I_LRU = 16 * 16, NITEMS = I_IN + 3 * I_SQ + I_LRU;
#define P0_DESC(IT, W_, K_, N_, WT_, RO_, LI_) do { int r_ = (IT) < NITEMS ? (IT) : NITEMS - 1;   \
            if (r_ < I_IN) { const int n0_ = (r_ % (INW / 64)) * 64; int ro_ = 0;     \
                if (n0_ >= 6656) { const int c_ = n0_ - 6656, isgl_ = c_ >> 11, cc_ = c_ & 2047; ro_ = 6656 + (cc_ >> 7) * 256 + isgl_ * 128 + (cc_ & 127) - n0_; } \
                W_ = a.w_in; K_ = DM; N_ = INW; WT_ = Wt_in; RO_ = ro_; LI_ = r_; } \
            else if (r_ < I_IN + I_SQ) { W_ = a.w_o_attn; K_ = DM; N_ = DM; WT_ = Wt_oa; RO_ = 0; LI_ = r_ - I_IN; } \
            else if (r_ < I_IN + 2 * I_SQ) { W_ = a.w_o_lru; K_ = DM; N_ = DM; WT_ = Wt_ol; RO_ = 0; LI_ = r_ - I_IN - I_SQ; } \
            else if (r_ < I_IN + 3 * I_SQ) { W_ = a.w_out; K_ = DM; N_ = DM; WT_ = Wt_out; RO_ = 0; LI_ = r_ - I_IN - 2 * I_SQ; } \
            else { const int q_ = r_ - I_IN - 3 * I_SQ, mat_ = q_ >> 4, which_ = mat_ >> 3, n_ = mat_ & 7; \
                W_ = (which_ ? a.lru_wi : a.lru_wa) + (size_t)n_ * 65536; K_ = 256; N_ = 256; WT_ = which_ ? Wt_i : Wt_a; RO_ = n_ * 256; LI_ = q_ & 15; } } while (0)
        {
            f32x4 va[16], vb[16], vc[16];
            const float* wA; bf16_t* tA; int kA, nA, rA, lA; const float* wB; bf16_t* tB; int kB, nB, rB, lB; const float* wC; bf16_t* tC; int kC, nC, rC, lC;
            P0_DESC(gw, wA, kA, nA, tA, rA, lA); transpose_load(va, wA, nA, lA, lane);
            P0_DESC(gw + NGW, wB, kB, nB, tB, rB, lB); transpose_load(vb, wB, nB, lB, lane);
#pragma unroll 1
            for (int it = gw; it < NITEMS; it += 3 * NGW) {
                P0_DESC(it + 2 * NGW, wC, kC, nC, tC, rC, lC); transpose_load(vc, wC, nC, lC, lane);
                transpose_store(va, kA, nA, tA, rA, scr, lA, lane);
                P0_DESC(it + 3 * NGW, wA, kA, nA, tA, rA, lA); transpose_load(va, wA, nA, lA, lane);
                transpose_store(vb, kB, nB, tB, rB, scr, lB, lane);
                P0_DESC(it + 4 * NGW, wB, kB, nB, tB, rB, lB); transpose_load(vb, wB, nB, lB, lane);
                transpose_store(vc, kC, nC, tC, rC, scr, lC, lane);
            }
        }
#undef P0_DESC
        {
            const f32x4* gr = (const f32x4*)a.norm1_g + lane; f32x4 gv[8];
#pragma unroll
            for (int j = 0; j < 8; ++j) gv[j] = gr[64 * j];
#define P0_ROWSRC(M) ((M) < MR ? a.x + (size_t)(M) * DM : a.meta + (size_t)(((M) < MR + NMETA ? (M) : MR + NMETA - 1) - MR) * DM)
            f32x4 vn[8];
            { const f32x4* xr = (const f32x4*)P0_ROWSRC(gw) + lane;
#pragma unroll
              for (int j = 0; j < 8; ++j) vn[j] = __builtin_nontemporal_load(xr + 64 * j); }
#pragma unroll 1
            for (int m = gw; m < MR + NMETA; m += NGW) {
                f32x4 v[8];
#pragma unroll
                for (int j = 0; j < 8; ++j) v[j] = vn[j];
                { const f32x4* xr = (const f32x4*)P0_ROWSRC(m + NGW) + lane;
#pragma unroll
                  for (int j = 0; j < 8; ++j) vn[j] = __builtin_nontemporal_load(xr + 64 * j); }
                float ssq = 0.f;
#pragma unroll
                for (int j = 0; j < 8; ++j) ssq += (v[j][0] * v[j][0] + v[j][1] * v[j][1]) + (v[j][2] * v[j][2] + v[j][3] * v[j][3]);
                const float rs = 1.0f / sqrtf(wave_sum(ssq) * (1.0f / DM) + EPS);
                u32x2* o8 = (u32x2*)(XN + (size_t)m * DM) + lane;
#pragma unroll
                for (int j = 0; j < 8; ++j) { u32x2 w; w.x = cvt_pk_bf16(v[j][0] * rs * gv[j][0], v[j][1] * rs * gv[j][1]); w.y = cvt_pk_bf16(v[j][2] * rs * gv[j][2], v[j][3] * rs * gv[j][3]); o8[64 * j] = w; }
            }
#undef P0_ROWSRC
            for (int m = MR + NMETA + gw; m < MPAD; m += NGW) { u32x4* o = (u32x4*)(XN + (size_t)m * DM) + lane;
#pragma unroll
                for (int j = 0; j < 4; ++j) o[64 * j] = (u32x4){0u, 0u, 0u, 0u}; }
        }
        for (int i = bid * NTHREADS + tid; i < MR; i += G * NTHREADS) rowss[i] = 0.f;
    }
    SEAM(0);

    if (IN(1)) {
        const int NT_CU = (G >= 128) ? (G * 30) / 256 : 0, NG = G - NT_CU;
        if (bid < NG) {
            SchedIn S{(const char*)XN, (const char*)Wt_in, NG, bid};
            EpiIn E{Qb, Kb, Vb, LX, LG, GA, GL};
            pg8::gemm_phase<EpiIn, SchedIn>(lds, DM, S, E);
        }
        if (bid >= NG || NT_CU == 0) {
            LAS float* scr = (LAS float*)(lds + wave * 16640);
            const int gw = (NT_CU ? bid - NG : bid) * NWAVES + wave, NGW = (NT_CU ? NT_CU : G) * NWAVES;
            constexpr int I_UP = 32 * 128, I_DN = 128 * 32, NIT = I_UP + I_DN;
#define TR_LOAD(v, IT) do { const int it_ = (IT) < NIT ? (IT) : NIT - 1; const bool up_ = it_ < I_UP; transpose_load(v, up_ ? a.w_up : a.w_down, up_ ? FF : DM, up_ ? it_ : it_ - I_UP, lane); } while (0)
#define TR_STORE(v, IT) do { const int it_ = (IT) < NIT ? (IT) : NIT - 1; const bool up_ = it_ < I_UP; transpose_store<true>(v, up_ ? DM : FF, up_ ? FF : DM, up_ ? Wt_up : Wt_dn, 0, scr, up_ ? it_ : it_ - I_UP, lane); } while (0)
            f32x4 va[16], vb[16];
            TR_LOAD(va, gw);
#pragma unroll 1
            for (int it = gw; it < NIT; it += 2 * NGW) {
                TR_LOAD(vb, it + NGW);
                TR_STORE(va, it);
                TR_LOAD(va, it + 2 * NGW);
                TR_STORE(vb, it + NGW);
            }
#undef TR_LOAD
#undef TR_STORE
        }
    }
    SEAM(1);

    {
        if (IN(3)) {
            constexpr int KS_STRIDE = 144  , VT_STRIDE = 552  , VT_OFF = 39424;
            const int fr = lane & 15, fq = lane >> 4;
            for (int unit = bid; unit < 256; unit += G) {
                const int b = unit >> 6, qb = (unit >> 2) & 15, g = unit & 3;
                {
                    const int ch = tid & 7;
                    float gk[8];
#pragma unroll
                    for (int e = 0; e < 8; ++e) gk[e] = a.k_norm_g[ch * 8 + e];
                    u32x4 kws[5], vws[5];
#pragma unroll
                    for (int it = 0; it < 5; ++it) {
                        const int key = (it * NTHREADS + tid) >> 3;
                        bool ld = key < 272; int row = 0;
                        if (key < 16) row = MR + key;
                        else { const int ik = key - 16; row = b * SEQ + qb * 128 - 128 + ik; if (qb == 0 && ik < 128) ld = false; }
                        kws[it] = (u32x4){0u, 0u, 0u, 0u}; vws[it] = (u32x4){0u, 0u, 0u, 0u};
                        if (ld) { kws[it] = *(const u32x4*)(Kb + (size_t)row * KVW + g * 64 + ch * 8); vws[it] = *(const u32x4*)(Vb + (size_t)row * KVW + g * 64 + ch * 8); }
                    }
#pragma unroll
                    for (int it = 0; it < 5; ++it) {
                        const int key = (it * NTHREADS + tid) >> 3;
                        const u32x4 kw = kws[it], vw = vws[it];
                        float kf[8] = {bf_lo(kw.x), bf_hi(kw.x), bf_lo(kw.y), bf_hi(kw.y), bf_lo(kw.z), bf_hi(kw.z), bf_lo(kw.w), bf_hi(kw.w)};
                        float ss = 0.f;
#pragma unroll
                        for (int e = 0; e < 8; ++e) ss += kf[e] * kf[e];
                        ss += __shfl_xor(ss, 1); ss += __shfl_xor(ss, 2); ss += __shfl_xor(ss, 4);
                        const float sc = 1.0f / sqrtf(ss * (1.0f / 64.0f) + EPS);
                        if (key < 272) {
                            u32x4 o; o.x = cvt_pk_bf16(kf[0] * sc * gk[0], kf[1] * sc * gk[1]); o.y = cvt_pk_bf16(kf[2] * sc * gk[2], kf[3] * sc * gk[3]);
                            o.z = cvt_pk_bf16(kf[4] * sc * gk[4], kf[5] * sc * gk[5]); o.w = cvt_pk_bf16(kf[6] * sc * gk[6], kf[7] * sc * gk[7]);
                            *(LAS u32x4*)(lds + key * KS_STRIDE + ch * 16) = o;
                            LAS bf16_t* vt = (LAS bf16_t*)(lds + VT_OFF + (ch * 8) * VT_STRIDE + key * 2);
                            vt[0 * (VT_STRIDE / 2)] = (bf16_t)(vw.x & 0xffffu); vt[1 * (VT_STRIDE / 2)] = (bf16_t)(vw.x >> 16);
                            vt[2 * (VT_STRIDE / 2)] = (bf16_t)(vw.y & 0xffffu); vt[3 * (VT_STRIDE / 2)] = (bf16_t)(vw.y >> 16);
                            vt[4 * (VT_STRIDE / 2)] = (bf16_t)(vw.z & 0xffffu); vt[5 * (VT_STRIDE / 2)] = (bf16_t)(vw.z >> 16);
                            vt[6 * (VT_STRIDE / 2)] = (bf16_t)(vw.w & 0xffffu); vt[7 * (VT_STRIDE / 2)] = (bf16_t)(vw.w >> 16);
                        }
                    }
                }
                __syncthreads();
                const int h = g * 8 + wave;
                const float sinkl = a.sinks[h] * LOG2E;
                float gq[16];
#pragma unroll
                for (int e = 0; e < 8; ++e) { gq[e] = a.q_norm_g[8 * fq + e]; gq[8 + e] = a.q_norm_g[32 + 8 * fq + e]; }
                u32x4 q0n, q1n;
                { const bf16_t* qp0 = Qb + (size_t)(b * SEQ + qb * 128 + fr) * DM + h * 64; q0n = *(const u32x4*)(qp0 + 8 * fq); q1n = *(const u32x4*)(qp0 + 32 + 8 * fq); }
#pragma unroll 1
                for (int mt = 0; mt < 8; ++mt) {
                    const size_t qrow = (size_t)(b * SEQ + qb * 128 + mt * 16 + fr);
                    const u32x4 q0 = q0n, q1 = q1n;
                    { const bf16_t* qpn = Qb + (qrow + (mt < 7 ? 16 : 0)) * DM + h * 64; q0n = *(const u32x4*)(qpn + 8 * fq); q1n = *(const u32x4*)(qpn + 32 + 8 * fq); }
                    float qf[16] = {bf_lo(q0.x), bf_hi(q0.x), bf_lo(q0.y), bf_hi(q0.y), bf_lo(q0.z), bf_hi(q0.z), bf_lo(q0.w), bf_hi(q0.w),
                                    bf_lo(q1.x), bf_hi(q1.x), bf_lo(q1.y), bf_hi(q1.y), bf_lo(q1.z), bf_hi(q1.z), bf_lo(q1.w), bf_hi(q1.w)};
                    float ss = 0.f;
#pragma unroll
                    for (int e = 0; e < 16; ++e) ss += qf[e] * qf[e];
                    ss += __shfl_xor(ss, 16); ss += __shfl_xor(ss, 32);
                    const float sc = (0.125f * LOG2E) / sqrtf(ss * (1.0f / 64.0f) + EPS);
                    u32x4 qa, qc;
                    qa.x = cvt_pk_bf16(qf[0] * sc * gq[0], qf[1] * sc * gq[1]); qa.y = cvt_pk_bf16(qf[2] * sc * gq[2], qf[3] * sc * gq[3]);
                    qa.z = cvt_pk_bf16(qf[4] * sc * gq[4], qf[5] * sc * gq[5]); qa.w = cvt_pk_bf16(qf[6] * sc * gq[6], qf[7] * sc * gq[7]);
                    qc.x = cvt_pk_bf16(qf[8] * sc * gq[8], qf[9] * sc * gq[9]); qc.y = cvt_pk_bf16(qf[10] * sc * gq[10], qf[11] * sc * gq[11]);
                    qc.z = cvt_pk_bf16(qf[12] * sc * gq[12], qf[13] * sc * gq[13]); qc.w = cvt_pk_bf16(qf[14] * sc * gq[14], qf[15] * sc * gq[15]);
                    const bf16x8 qfr0 = __builtin_bit_cast(bf16x8, qa), qfr1 = __builtin_bit_cast(bf16x8, qc);
                    f32x4 st[10];
#pragma unroll
                    for (int j = 0; j < 10; ++j) {
                        const int kbase = (j == 0) ? 0 : 16 + 16 * (mt + j - 1);
                        const LAS unsigned char* kp = lds + (kbase + fr) * KS_STRIDE + fq * 16;
                        const bf16x8 k0 = *(const LAS bf16x8*)(kp), k1 = *(const LAS bf16x8*)(kp + 64);
                        f32x4 s = (f32x4){0.f, 0.f, 0.f, 0.f};
                        s = __builtin_amdgcn_mfma_f32_16x16x32_bf16(k0, qfr0, s, 0, 0, 0);
                        s = __builtin_amdgcn_mfma_f32_16x16x32_bf16(k1, qfr1, s, 0, 0, 0);
                        st[j] = s;
                    }
#pragma unroll
                    for (int r = 0; r < 4; ++r) { const int d1 = 4 * fq + r - fr; st[1][r] = (d1 >= 1) ? st[1][r] : -1e30f; st[9][r] = (d1 <= 0) ? st[9][r] : -1e30f; }
                    if (qb == 0) {
#pragma unroll
                        for (int j = 1; j < 10; ++j)
#pragma unroll
                            for (int r = 0; r < 4; ++r) st[j][r] = ((16 * (mt + j - 1) + 4 * fq + r) < 128) ? -1e30f : st[j][r];
                    }
                    float mx = sinkl;
#pragma unroll
                    for (int j = 0; j < 10; ++j) mx = fmaxf(fmaxf(mx, fmaxf(st[j][0], st[j][1])), fmaxf(st[j][2], st[j][3]));
                    mx = fmaxf(mx, __shfl_xor(mx, 16)); mx = fmaxf(mx, __shfl_xor(mx, 32));
                    float den = 0.f;
#pragma unroll
                    for (int j = 0; j < 10; ++j)
#pragma unroll
                        for (int r = 0; r < 4; ++r) { const float p = __builtin_amdgcn_exp2f(st[j][r] - mx); st[j][r] = p; den += p; }
                    den += __shfl_xor(den, 16); den += __shfl_xor(den, 32);
                    den += __builtin_amdgcn_exp2f(sinkl - mx);
                    const float rden = 1.0f / den;
                    f32x4 o[4];
#pragma unroll
                    for (int dt = 0; dt < 4; ++dt) o[dt] = (f32x4){0.f, 0.f, 0.f, 0.f};
#pragma unroll
                    for (int kp = 0; kp < 5; ++kp) {
                        u32x4 pw; pw.x = cvt_pk_bf16(st[2 * kp][0], st[2 * kp][1]); pw.y = cvt_pk_bf16(st[2 * kp][2], st[2 * kp][3]);
                        pw.z = cvt_pk_bf16(st[2 * kp + 1][0], st[2 * kp + 1][1]); pw.w = cvt_pk_bf16(st[2 * kp + 1][2], st[2 * kp + 1][3]);
                        const bf16x8 pfr = __builtin_bit_cast(bf16x8, pw);
                        const int kb0 = (kp == 0) ? 0 : 16 + 16 * (mt + 2 * kp - 1), kb1 = 16 + 16 * (mt + 2 * kp);
#pragma unroll
                        for (int dt = 0; dt < 4; ++dt) {
                            const LAS unsigned char* vp = lds + VT_OFF + (16 * dt + fr) * VT_STRIDE + 8 * fq;
                            const u32x2 va = *(const LAS u32x2*)(vp + 2 * kb0), vb = *(const LAS u32x2*)(vp + 2 * kb1);
                            const u32x4 vv = (u32x4){va.x, va.y, vb.x, vb.y};
                            o[dt] = __builtin_amdgcn_mfma_f32_16x16x32_bf16(__builtin_bit_cast(bf16x8, vv), pfr, o[dt], 0, 0, 0);
                        }
                    }
#pragma unroll
                    for (int dt = 0; dt < 4; ++dt) { u32x2 w; w.x = cvt_pk_bf16(o[dt][0] * rden, o[dt][1] * rden); w.y = cvt_pk_bf16(o[dt][2] * rden, o[dt][3] * rden);
                        *(u32x2*)(Ob + qrow * DM + h * 64 + 16 * dt + 4 * fq) = w; }
                }
                __syncthreads();
            }
        }
        if (IN(4)) {
            constexpr int AT_STRIDE = 528  , WL_OFF = 67584, AB_OFF = 101376, BB_OFF = 117888, SEG_OFF = 134400, CARRY_OFF = 138496, GC_OFF = 138752, CW_OFF = 139136, ABS = 129  ;
            static_assert(CW_OFF + 5120 <= LDS_BYTES, "LRU LDS map");
            const int fr = lane & 15, fq = lane >> 4;
            for (int item = bid; item < 256; item += G) {
                const int b = item >> 6, n = (item >> 3) & 7, d0 = (item & 7) * 32, cb = n * 256 + d0;
                const int cg8 = tid & 31, seg = tid >> 5; const int cch = n * 256 + cg8 * 8;
                {
                    u32x4 wtmp[4]; float ctmp[3], gtmp[3];
#pragma unroll
                    for (int k = 0; k < 4; ++k) { const int i = tid + k * NTHREADS, gate = i >> 10, dd = (i >> 5) & 31, kc = i & 31;
                        wtmp[k] = *(const u32x4*)((gate ? Wt_i : Wt_a) + (size_t)(n * 256 + d0 + dd) * 256 + kc * 8); }
#pragma unroll
                    for (int k = 0; k < 3; ++k) { const int i = tid + k * NTHREADS, ic = i < 1280 ? i : 1279, tp = ic >> 8, c = ic & 255;
                        const float* src = (tp < 4) ? a.conv_w + tp * DM + n * 256 + c : a.conv_b + n * 256 + c; ctmp[k] = *src; }
                    { const int ch = cb + (tid & 31); gtmp[0] = a.lru_lambda[ch]; gtmp[1] = a.lru_ba[ch]; gtmp[2] = a.lru_bi[ch]; }
#pragma unroll
                    for (int k = 0; k < 4; ++k) { const int i = tid + k * NTHREADS, gate = i >> 10, dd = (i >> 5) & 31, kc = i & 31;
                        *(LAS u32x4*)(lds + WL_OFF + (gate * 32 + dd) * AT_STRIDE + kc * 16) = wtmp[k]; }
#pragma unroll
                    for (int k = 0; k < 3; ++k) { const int i = tid + k * NTHREADS; if (i < 1280) ((LAS float*)(lds + CW_OFF))[i] = ctmp[k]; }
                    if (tid < 32) { const float lam = gtmp[0];
                        ((LAS float*)(lds + GC_OFF))[tid] = (lam > 15.f) ? __expf(-lam) : log1pf(__expf(-lam)); ((LAS float*)(lds + GC_OFF))[32 + tid] = gtmp[1]; ((LAS float*)(lds + GC_OFF))[64 + tid] = gtmp[2]; }
                    if (tid < 64) ((LAS float*)(lds + CARRY_OFF))[tid] = 0.f;
                }
                __syncthreads();
                const u32x4 zero4 = (u32x4){0u, 0u, 0u, 0u};
                const int sch0 = tid & 31, seg0 = seg, fr0 = fr, fq0 = fq, cg80 = cg8;
#define LRU_LOAD_ROWS(TI) do { const bf16_t* base_ = LX + ((long)(b * 2064 + ((TI) == 0 ? 0 : 16 + ((TI) - 1) * 128) + seg * 8 - 3)) * DM + cch; \
                    _Pragma("unroll") for (int q_ = 0; q_ < 11; ++q_) { const bool ok_ = !((TI) == 0 && seg == 0 && q_ < 3); lxr[q_] = zero4; if (ok_) lxr[q_] = *(const u32x4*)(base_ + (long)q_ * DM); } } while (0)
                u32x4 lxr[11];
                LRU_LOAD_ROWS(0);
#pragma unroll 1
                for (int ti = 0; ti < 17; ++ti) {
                    int seg = seg0, sch = sch0, fr = fr0, fq = fq0, cg8 = cg80;
                    asm volatile("" : "+v"(seg), "+v"(sch), "+v"(fr), "+v"(fq), "+v"(cg8));
                    {
                        f32x2 win[3][4], cw[4][4], cbias[4];
#pragma unroll
                        for (int p = 0; p < 4; ++p) { win[0][p] = (f32x2){0.f, 0.f}; win[1][p] = (f32x2){0.f, 0.f}; win[2][p] = (f32x2){0.f, 0.f}; }
#pragma unroll
                        for (int tp = 0; tp < 5; ++tp) { const f32x4 c0 = *(const LAS f32x4*)(lds + CW_OFF + (tp * 256 + cg8 * 8) * 4), c1 = *(const LAS f32x4*)(lds + CW_OFF + (tp * 256 + cg8 * 8 + 4) * 4);
                            if (tp < 4) { cw[tp & 3][0] = (f32x2){c0[0], c0[1]}; cw[tp & 3][1] = (f32x2){c0[2], c0[3]}; cw[tp & 3][2] = (f32x2){c1[0], c1[1]}; cw[tp & 3][3] = (f32x2){c1[2], c1[3]}; }
                            else { cbias[0] = (f32x2){c0[0], c0[1]}; cbias[1] = (f32x2){c0[2], c0[3]}; cbias[2] = (f32x2){c1[0], c1[1]}; cbias[3] = (f32x2){c1[2], c1[3]}; } }
#pragma unroll
                        for (int q = 0; q < 11; ++q) {
                            const u32x4 w = lxr[q];
                            const f32x2 cur[4] = {(f32x2){bf_lo(w.x), bf_hi(w.x)}, (f32x2){bf_lo(w.y), bf_hi(w.y)}, (f32x2){bf_lo(w.z), bf_hi(w.z)}, (f32x2){bf_lo(w.w), bf_hi(w.w)}};
                            if (q >= 3) {
                                f32x2 y[4];
#pragma unroll
                                for (int p = 0; p < 4; ++p) y[p] = __builtin_elementwise_fma(cur[p], cw[3][p], __builtin_elementwise_fma(win[2][p], cw[2][p], __builtin_elementwise_fma(win[1][p], cw[1][p], __builtin_elementwise_fma(win[0][p], cw[0][p], cbias[p]))));
                                u32x4 o; o.x = cvt_pk_bf16(y[0][0], y[0][1]); o.y = cvt_pk_bf16(y[1][0], y[1][1]); o.z = cvt_pk_bf16(y[2][0], y[2][1]); o.w = cvt_pk_bf16(y[3][0], y[3][1]);
                                *(LAS u32x4*)(lds + (seg * 8 + q - 3) * AT_STRIDE + cg8 * 16) = o;
                            }
#pragma unroll
                            for (int p = 0; p < 4; ++p) { win[0][p] = win[1][p]; win[1][p] = win[2][p]; win[2][p] = cur[p]; }
                        }
                    }
                    const size_t row0 = (size_t)(b * SEQ + (ti > 0 ? ti - 1 : 0) * 128 + 8 * seg);
                    unsigned lgv[8];
                    { const bf16_t* lgp = LG + row0 * DM + cb + sch;
#pragma unroll
                      for (int j = 0; j < 8; ++j) lgv[j] = lgp[(size_t)j * DM]; }
                    { const int tn = ti < 16 ? ti + 1 : 16; LRU_LOAD_ROWS(tn); }
                    WG_BAR();
                    {
                        f32x4 acc[2][2];
#pragma unroll
                        for (int gt = 0; gt < 2; ++gt)
#pragma unroll
                            for (int nt = 0; nt < 2; ++nt) acc[gt][nt] = (f32x4){0.f, 0.f, 0.f, 0.f};
#pragma unroll
                        for (int ks = 0; ks < 8; ++ks) {
                            const bf16x8 af = *(const LAS bf16x8*)(lds + (16 * wave + fr) * AT_STRIDE + ks * 64 + fq * 16);
#pragma unroll
                            for (int gt = 0; gt < 2; ++gt)
#pragma unroll
                                for (int nt = 0; nt < 2; ++nt) {
                                    const bf16x8 wf = *(const LAS bf16x8*)(lds + WL_OFF + (gt * 32 + 16 * nt + fr) * AT_STRIDE + ks * 64 + fq * 16);
                                    acc[gt][nt] = __builtin_amdgcn_mfma_f32_16x16x32_bf16(wf, af, acc[gt][nt], 0, 0, 0);
                                }
                        }
                        const int tk = 16 * wave + fr;
#pragma unroll
                        for (int nt = 0; nt < 2; ++nt)
#pragma unroll
                            for (int r = 0; r < 4; ++r) {
                                const int ch = 16 * nt + 4 * fq + r;
                                const float splv = ((LAS float*)(lds + GC_OFF))[ch], bavv = ((LAS float*)(lds + GC_OFF))[32 + ch], bivv = ((LAS float*)(lds + GC_OFF))[64 + ch];
                                const float rg = fast_sigmoid(acc[0][nt][r] + bavv), ig = fast_sigmoid(acc[1][nt][r] + bivv);
                                const float la = -8.0f * rg * splv;
                                const float av = __builtin_amdgcn_exp2f(la * LOG2E);
                                const float t2 = 2.0f * la;
                                const float m2s = -t2 * (1.0f + t2 * (0.5f + t2 * (0.16666667f + t2 * (0.041666668f + t2 * (0.0083333338f + t2 * 0.0013888889f)))));
                                const float m2 = (t2 > -0.25f) ? m2s : (1.0f - av * av);
                                float mult = __builtin_amdgcn_sqrtf(fmaxf(m2, 0.f));
                                if (ti == 0 && tk == 0) mult = 1.0f;
                                const float xv = bf2f(*(const LAS bf16_t*)(lds + tk * AT_STRIDE + (d0 + ch) * 2));
                                ((LAS float*)(lds + AB_OFF))[ch * ABS + tk] = av;
                                ((LAS float*)(lds + BB_OFF))[ch * ABS + tk] = mult * ig * xv;
                            }
                    }
                    WG_BAR();
                    {
                        float A = 1.f, H = 0.f;
#pragma unroll
                        for (int j = 0; j < 8; ++j) { const float av = ((LAS float*)(lds + AB_OFF))[sch * ABS + 8 * seg + j], bv = ((LAS float*)(lds + BB_OFF))[sch * ABS + 8 * seg + j]; H = av * H + bv; A *= av; }
                        ((LAS f32x2*)(lds + SEG_OFF))[seg * 32 + sch] = (f32x2){A, H};
                    }
                    WG_BAR();
                    {
#pragma unroll
                        for (int j = 0; j < 8; ++j) asm volatile("" : "+v"(lgv[j]));
                        float hst = ((LAS float*)(lds + CARRY_OFF))[(ti & 1) * 32 + sch];
                        f32x2 shs[15];
#pragma unroll
                        for (int s2 = 0; s2 < 15; ++s2) shs[s2] = ((LAS f32x2*)(lds + SEG_OFF))[s2 * 32 + sch];
#pragma unroll
                        for (int s2 = 0; s2 < 15; ++s2) hst = (s2 < seg) ? shs[s2].x * hst + shs[s2].y : hst;
#pragma unroll
                        for (int j = 0; j < 8; ++j) { const float av = ((LAS float*)(lds + AB_OFF))[sch * ABS + 8 * seg + j], bv = ((LAS float*)(lds + BB_OFF))[sch * ABS + 8 * seg + j]; hst = av * hst + bv;
                            if (ti > 0) REC[(row0 + j) * DM + cb + sch] = (bf16_t)(cvt_pk_bf16(__uint_as_float(lgv[j] << 16) * hst, 0.f) & 0xffffu); }
                        const int lastseg = (ti == 0) ? 1 : 15;
                        if (seg == lastseg) ((LAS float*)(lds + CARRY_OFF))[((ti + 1) & 1) * 32 + sch] = hst;
                    }
                }
#undef LRU_LOAD_ROWS
                __syncthreads();
            }
        }
    }
    SEAM(4);

    if (IN(5)) {
        SchedMix S{(const char*)Ob, (const char*)REC, (const char*)Wt_oa, (const char*)Wt_ol, G, bid};
        EpiMix E{GA, GL, MIX};
        pg8::gemm_phase<EpiMix, SchedMix, true>(lds, 2 * DM, S, E);
    }
    SEAM(5);

    if (IN(6)) {
        SchedPlain S{(const char*)MIX, (const char*)Wt_out, 32, 8, DM, G, bid};
        EpiRes E{a.x, a.norm2_g, a.out, HG, rowss, a.flags & 1};
        pg8::gemm_phase<EpiRes, SchedPlain>(lds, DM, S, E);
    }
    SEAM(6);

    if (IN(7)) {
        SchedPlain S{(const char*)HG, (const char*)Wt_up, 32, 32, DM, G, bid};
        EpiUp E{rowss, U};
        pg8::gemm_phase<EpiUp, SchedPlain>(lds, DM, S, E);
    }
    SEAM(7);

    if (IN(8)) {
        SchedPlain S{(const char*)U, (const char*)Wt_dn, 32, 8, FF, G, bid};
        EpiDown E{a.out, a.flags & 2};
        pg8::gemm_phase<EpiDown, SchedPlain>(lds, FF, S, E);
    }
#undef IN
#undef SEAM
}

extern "C" void kernel_launch(void* const* d_in, const int* in_sizes, int n_in, void* d_out, int out_size, void* d_ws, size_t ws_size, hipStream_t stream) {
    static int grid = 0;
    if (grid == 0) {
        if (n_in != 20 || ws_size < WS_END) { fprintf(stderr, "kernel_launch: unexpected inputs (n_in %d, ws %zu)\n", n_in, ws_size); grid = -1; return; }
        int dev = 0, cus = 0, per_cu = 0;
        hipGetDevice(&dev);
        hipDeviceGetAttribute(&cus, hipDeviceAttributeMultiprocessorCount, dev);
        if (hipFuncSetAttribute((const void*)fwd_kernel, hipFuncAttributeMaxDynamicSharedMemorySize, LDS_BYTES) != hipSuccess) { fprintf(stderr, "kernel_launch: hipFuncSetAttribute failed\n"); grid = -1; return; }
        if (hipOccupancyMaxActiveBlocksPerMultiprocessor(&per_cu, (const void*)fwd_kernel, NTHREADS, LDS_BYTES) != hipSuccess || per_cu < 1) { fprintf(stderr, "kernel_launch: occupancy query says %d\n", per_cu); per_cu = 1; }
        (void)hipGetLastError();
        grid = cus * per_cu;
    }
    if (grid < 0) return;
    Args a{};
    a.x = (const float*)d_in[0]; a.meta = (const float*)d_in[1]; a.norm1_g = (const float*)d_in[2]; a.w_in = (const float*)d_in[3];
    a.q_norm_g = (const float*)d_in[4]; a.k_norm_g = (const float*)d_in[5]; a.sinks = (const float*)d_in[6]; a.w_o_attn = (const float*)d_in[7];
    a.conv_w = (const float*)d_in[8]; a.conv_b = (const float*)d_in[9]; a.lru_wa = (const float*)d_in[10]; a.lru_ba = (const float*)d_in[11];
    a.lru_wi = (const float*)d_in[12]; a.lru_bi = (const float*)d_in[13]; a.lru_lambda = (const float*)d_in[14]; a.w_o_lru = (const float*)d_in[15];
    a.w_out = (const float*)d_in[16]; a.norm2_g = (const float*)d_in[17]; a.w_up = (const float*)d_in[18]; a.w_down = (const float*)d_in[19];
    a.out = (float*)d_out; a.ws = (unsigned char*)d_ws;
    if (hipMemsetAsync((unsigned char*)d_ws + WS_BAR, 0, WS_BAR_BYTES, stream) != hipSuccess) { fprintf(stderr, "kernel_launch: memset of the barrier words failed\n"); return; }
#if MK_MULTI
    for (int ph = 0; ph < 9; ++ph) {
        a.ph_lo = ph; a.ph_hi = ph + 1; a.flags = 0;
        void* args[] = {&a};
        hipError_t e = hipLaunchCooperativeKernel((const void*)fwd_kernel, dim3(grid), dim3(NTHREADS), args, LDS_BYTES, stream);
        if (e != hipSuccess) { fprintf(stderr, "cooperative launch (phase %d) failed: %s (grid %d)\n", ph, hipGetErrorString(e), grid); break; }
    }
#elif PROBE_DUP >= 0
    for (int li = 0; li < 2; ++li) {
        a.ph_lo = li ? PROBE_DUP : 0; a.ph_hi = li ? 9 : PROBE_DUP + 1; a.flags = (li << 8) | (li ? 0 : (PROBE_DUP == 6 ? 1 : (PROBE_DUP == 8 ? 2 : 0)));
        void* args[] = {&a};
        hipError_t e = hipLaunchCooperativeKernel((const void*)fwd_kernel, dim3(grid), dim3(NTHREADS), args, LDS_BYTES, stream);
        if (e != hipSuccess) { fprintf(stderr, "cooperative launch failed: %s (grid %d)\n", hipGetErrorString(e), grid); break; }
    }
#else
    a.ph_lo = 0; a.ph_hi = 9;
    void* args[] = {&a};
    hipError_t e = hipLaunchCooperativeKernel((const void*)fwd_kernel, dim3(grid), dim3(NTHREADS), args, LDS_BYTES, stream);
    if (e != hipSuccess) fprintf(stderr, "cooperative launch failed: %s (grid %d)\n", hipGetErrorString(e), grid);
#endif
}
```

```cpp
#include <hip/hip_runtime.h>
#include <hip/hip_cooperative_groups.h>
#include <cstdio>
#include <cstdint>
namespace cg = cooperative_groups;

#ifndef MK_MULTI
#define MK_MULTI 0
#endif

#ifndef PROBE_DUP
#define PROBE_DUP -1
#endif

#define LAS __attribute__((address_space(3)))
typedef unsigned short bf16_t;
typedef short bf16x8 __attribute__((ext_vector_type(8)));
typedef float f32x4 __attribute__((ext_vector_type(4)));
typedef float f32x2 __attribute__((ext_vector_type(2)));
typedef unsigned u32x4 __attribute__((ext_vector_type(4)));
typedef unsigned u32x2 __attribute__((ext_vector_type(2)));

constexpr int DM = 2048, NBATCH = 4, SEQ = 2048, MR = NBATCH * SEQ  , NMETA = 16, MPAD = 8448  ;
constexpr int INW = 10752, FF = 8192, KVW = 256;
constexpr float EPS = 1e-6f;
constexpr float LOG2E = 1.4426950408889634f;
constexpr int NTHREADS = 512, NWAVES = 8;
constexpr int LDS_BYTES = 147456;

constexpr size_t MiB = 1u << 20;
constexpr size_t WS_CTL = 0;
constexpr size_t WS_BAR = 65536, WS_BAR_BYTES = 65536;
constexpr size_t WS_R1 = 1 * MiB;
constexpr size_t WS_WTIN = WS_R1, WS_XN = WS_R1 + 42 * MiB;
constexpr size_t WS_WTUP = 272 * MiB, WS_WTDN = 304 * MiB;
constexpr size_t WS_WOA = 76 * MiB, WS_WOL = 84 * MiB, WS_WOUT = 92 * MiB, WS_WA = 100 * MiB, WS_WI = 101 * MiB;
constexpr size_t WS_Q = 102 * MiB;
constexpr size_t WS_K = 134 * MiB, WS_V = 134 * MiB + 4608 * 1024;
constexpr size_t WS_LX = 143 * MiB;
constexpr size_t WS_LG = 176 * MiB;
constexpr size_t WS_GA = 208 * MiB, WS_GL = 240 * MiB;
constexpr size_t WS_U = 143 * MiB;
#if PROBE_DUP == 3 || PROBE_DUP == 4
constexpr size_t WS_O = WS_R1, WS_REC = WS_R1 + 32 * MiB;
#else
constexpr size_t WS_O = WS_Q, WS_REC = WS_LG;
#endif
constexpr size_t WS_END = 336 * MiB;

typedef __bf16 bf16x2_t __attribute__((ext_vector_type(2)));
__device__ __forceinline__ unsigned cvt_pk_bf16(float lo, float hi) { const f32x2 v = {lo, hi}; const bf16x2_t b = __builtin_convertvector(v, bf16x2_t); return __builtin_bit_cast(unsigned, b); }
__device__ __forceinline__ float bf_lo(unsigned w) { return __uint_as_float(w << 16); }
__device__ __forceinline__ float bf_hi(unsigned w) { return __uint_as_float(w & 0xffff0000u); }
__device__ __forceinline__ float bf2f(bf16_t u) { return __uint_as_float((unsigned)u << 16); }
__device__ __forceinline__ float fast_sigmoid(float x) { return __builtin_amdgcn_rcpf(1.0f + __builtin_amdgcn_exp2f(-x * LOG2E)); }
__device__ __forceinline__ float gelu_tanh(float x) { const float y = 0.7978845608028654f * (x + 0.044715f * x * x * x); return x * __builtin_amdgcn_rcpf(1.0f + __builtin_amdgcn_exp2f(-2.0f * LOG2E * y)); }
#define LDS_WAIT() asm volatile("s_waitcnt lgkmcnt(0)" ::: "memory")
#define WG_BAR() do { asm volatile("s_waitcnt lgkmcnt(0)" ::: "memory"); __builtin_amdgcn_s_barrier(); asm volatile("" ::: "memory"); } while (0)

namespace pg8 {
constexpr int BM = 256, BK = 64, HALF = 128, HTB = HALF * BK * 2, STAGE_BYTES = 8 * HTB, NXCD = 8, WGM = 8;
__host__ __device__ __forceinline__ int lds_byte(int r, int c) { const int st = (r >> 4) * 2 + (c >> 5), rr = r & 15, cc = c & 31, ob = rr * 64 + cc * 2; return st * 1024 + (ob ^ (((ob >> 9) & 1) << 5)); }
__host__ __device__ __forceinline__ void stage_rc(int b, int& R, int& C) { const int st = b / 1024, sb = b % 1024, swz = sb ^ (((sb >> 9) & 1) << 5); R = (st >> 1) * 16 + swz / 64; C = (st & 1) * 32 + (swz % 64) / 2; }
__host__ __device__ __forceinline__ int perm32(int rho) { const int n = rho >> 4, i = rho & 15; return 8 * (i >> 2) + 4 * n + (i & 3); }

struct Unit { int pm, pn, sub; };

__device__ __forceinline__ void tile_of(int wgid, int nM, int nN, Unit& u) {
    const int nwg = nM * nN;
    { const int q = nwg / NXCD, r = nwg % NXCD, xcd = wgid % NXCD, off = wgid / NXCD; wgid = (xcd < r ? xcd * (q + 1) : r * (q + 1) + (xcd - r) * q) + off; }
    const int nig = WGM * nN, gid = wgid / nig, fm = gid * WGM, gsz = (nM - fm) < WGM ? (nM - fm) : WGM;
    u.pm = fm + ((wgid % nig) % gsz); u.pn = (wgid % nig) / gsz; u.sub = 0;
}

template <class Epi, class Sched, bool SPLITK = false>
__device__ __forceinline__ void gemm_phase(LAS unsigned char* lds, const int K, const Sched& S, const Epi& E) {
    const int tid = threadIdx.x, wid = __builtin_amdgcn_readfirstlane(tid >> 6), lane = tid & 63, wr = wid >> 2, wc = wid & 3, fr = lane & 15, fq = lane >> 4;
    const int nt = K / BK, nth = nt / 2, ld = SPLITK ? K / 2 : K;
    unsigned voffA[2], voffB[2];
#pragma unroll
    for (int i = 0; i < 2; ++i) { int R, C; stage_rc(tid * 16 + i * 8192, R, C); const int Rb = Epi::PERM ? ((R & ~31) + perm32(R & 31)) : R;
        voffA[i] = (unsigned)(R * ld + C) * 2u; voffB[i] = (unsigned)(Rb * ld + C) * 2u; }
    const size_t kstep = (size_t)(BK * 2);
    const size_t hstep = (size_t)HALF * ld * 2;
    const unsigned ldsw = (unsigned)wid * 1024u;
    const int aoff = lds_byte(wr * 64 + fr, fq * 8), boff = lds_byte(wc * 32 + fr, fq * 8);
#define PG8_SA(b, h) (((b) * 2 + (h)) * HTB)
#define PG8_SB(b, h) ((4 + (b) * 2 + (h)) * HTB)
#define PG8_STAGE(bufoff, gbase, voff) do { _Pragma("unroll") for (int _i = 0; _i < 2; ++_i) \
        __builtin_amdgcn_global_load_lds((const unsigned*)((const char*)(gbase) + (voff)[_i]), (LAS unsigned*)(lds + (bufoff) + ldsw + _i * 8192), 16, 0, 0); } while (0)
#define PG8_LDA(dst, b, h) do { _Pragma("unroll") for (int m = 0; m < 4; ++m) _Pragma("unroll") for (int k = 0; k < 2; ++k) dst[m][k] = *(const LAS bf16x8*)(lds + PG8_SA(b, h) + aoff + m * 2048 + k * 1024); } while (0)
#define PG8_LDB(dst, b, h) do { _Pragma("unroll") for (int n = 0; n < 2; ++n) _Pragma("unroll") for (int k = 0; k < 2; ++k) dst[n][k] = *(const LAS bf16x8*)(lds + PG8_SB(b, h) + boff + n * 2048 + k * 1024); } while (0)
#define PG8_MMA(ai, bj, At, Bt) do { __builtin_amdgcn_s_setprio(1); _Pragma("unroll") for (int m = 0; m < 4; ++m) _Pragma("unroll") for (int n = 0; n < 2; ++n) _Pragma("unroll") for (int k = 0; k < 2; ++k) \
        acc[ai][bj][m][n] = __builtin_amdgcn_mfma_f32_16x16x32_bf16(Bt[n][k], At[m][k], acc[ai][bj][m][n], 0, 0, 0); __builtin_amdgcn_s_setprio(0); } while (0)
#define PG8_WAIT_V(n) asm volatile("s_waitcnt vmcnt(" #n ")" ::: "memory")
#define PG8_WAIT_L(n) asm volatile("s_waitcnt lgkmcnt(" #n ")" ::: "memory")
#define PG8_BAR __builtin_amdgcn_s_barrier()
#define PG8_SCHED __builtin_amdgcn_sched_barrier(0)
    Unit cur, nxt; int ui = 0;
    if (!S.next(0, cur)) return;
    f32x4 acc[2][2][4][2];
    E.init(acc, cur, wr, wc, fr, fq);
    bf16x8 At[4][2], B0[2][2], B1[2][2];
    const char* cA = S.a_base(cur); const char* cB = S.b_base(cur);
    const char* cA2 = cA; const char* cB2 = cB;
    if constexpr (SPLITK) { cA2 = S.a_base2(cur); cB2 = S.b_base2(cur); }
#define PG8_KTA(j) ((SPLITK && (j) >= nth) ? cA2 + (size_t)((j) - nth) * kstep : cA + (size_t)(j) * kstep)
#define PG8_KTB(j) ((SPLITK && (j) >= nth) ? cB2 + (size_t)((j) - nth) * kstep : cB + (size_t)(j) * kstep)
    PG8_STAGE(PG8_SB(0, 0), cB, voffB); PG8_STAGE(PG8_SB(0, 1), cB + hstep, voffB); PG8_STAGE(PG8_SA(0, 0), cA, voffA); PG8_STAGE(PG8_SA(0, 1), cA + hstep, voffA);
    if (wr == 1) PG8_BAR;
    PG8_WAIT_V(2); PG8_BAR;
    PG8_STAGE(PG8_SB(1, 0), cB + kstep, voffB); PG8_STAGE(PG8_SA(1, 0), cA + kstep, voffA); PG8_STAGE(PG8_SB(1, 1), cB + hstep + kstep, voffB);
    PG8_WAIT_V(6); PG8_BAR;
    for (;;) {
        const bool has_next = S.next(ui + 1, nxt);
        const char* nA = has_next ? S.a_base(nxt) : cA; const char* nB = has_next ? S.b_base(nxt) : cB;
        for (int t = 0; t < nt; t += 2) {
            const bool last = (t == nt - 2);
            const char* a1 = PG8_KTA(t + 1);
            const char* a2 = last ? nA : PG8_KTA(t + 2); const char* b2 = last ? nB : PG8_KTB(t + 2);
            const char* a3 = last ? nA + kstep : PG8_KTA(t + 3); const char* b3 = last ? nB + kstep : PG8_KTB(t + 3);
            if constexpr (SPLITK) { if (t == nth) E.mid(acc, cur, wr, wc, fr, fq); }
            PG8_LDB(B0, 0, 0); PG8_LDB(B1, 0, 1); PG8_SCHED; PG8_LDA(At, 0, 0); PG8_STAGE(PG8_SA(1, 1), a1 + hstep, voffA);
            PG8_WAIT_V(8); PG8_WAIT_L(0); PG8_BAR; PG8_MMA(0, 0, At, B0); PG8_MMA(0, 1, At, B1); PG8_BAR; PG8_SCHED;
            PG8_LDA(At, 0, 1); PG8_STAGE(PG8_SB(0, 0), b2, voffB); PG8_STAGE(PG8_SB(0, 1), b2 + hstep, voffB); PG8_STAGE(PG8_SA(0, 0), a2, voffA);
            PG8_WAIT_V(8); PG8_WAIT_L(0); PG8_BAR; PG8_MMA(1, 0, At, B0); PG8_MMA(1, 1, At, B1); PG8_BAR; PG8_SCHED;
            PG8_LDB(B0, 1, 0); PG8_LDB(B1, 1, 1); PG8_SCHED; PG8_LDA(At, 1, 0); PG8_STAGE(PG8_SA(0, 1), a2 + hstep, voffA);
            PG8_WAIT_V(8); PG8_WAIT_L(0); PG8_BAR; PG8_MMA(0, 0, At, B0); PG8_MMA(0, 1, At, B1); PG8_BAR; PG8_SCHED;
            PG8_LDA(At, 1, 1); PG8_STAGE(PG8_SB(1, 0), b3, voffB); PG8_STAGE(PG8_SB(1, 1), b3 + hstep, voffB); PG8_STAGE(PG8_SA(1, 0), a3, voffA);
            PG8_WAIT_V(8); PG8_WAIT_L(0); PG8_BAR; PG8_MMA(1, 0, At, B0); PG8_MMA(1, 1, At, B1); PG8_BAR; PG8_SCHED;
        }
        if (wr == 0) PG8_BAR;
        E(acc, cur, wr, wc, fr, fq);
        if (!has_next) break;
        E.init(acc, nxt, wr, wc, fr, fq);
        cur = nxt; cA = nA; cB = nB; ++ui;
        if constexpr (SPLITK) { cA2 = S.a_base2(cur); cB2 = S.b_base2(cur); }
        if (wr == 1) PG8_BAR;
    }
    PG8_WAIT_V(0);
    PG8_BAR;
#undef PG8_KTA
#undef PG8_KTB
#undef PG8_SA
#undef PG8_SB
#undef PG8_STAGE
#undef PG8_LDA
#undef PG8_LDB
#undef PG8_MMA
#undef PG8_WAIT_V
#undef PG8_WAIT_L
#undef PG8_BAR
#undef PG8_SCHED
}
}
using pg8::Unit;

struct SchedIn {
    const char* A; const char* B; int G, c;
    __device__ __forceinline__ bool next(int i, Unit& u) const {
        const int L = i * G + c; constexpr int NREG = 32 * 42;
        if (L < NREG) { pg8::tile_of(L, 32, 42, u); return true; }
        if (L < NREG + 10) { u.pm = 32; u.pn = 8 + (L - NREG); u.sub = 0; return true; }
        return false;
    }
    __device__ __forceinline__ const char* a_base(const Unit& u) const { return A + (size_t)u.pm * (256u * DM * 2u); }
    __device__ __forceinline__ const char* b_base(const Unit& u) const { return B + (size_t)u.pn * (256u * DM * 2u); }
};
struct SchedMix {
    const char* A0; const char* A1; const char* B0; const char* B1; int G, c;
    __device__ __forceinline__ bool next(int i, Unit& u) const {
        const int L = i * G + c; if (L >= 32 * 8) return false;
        pg8::tile_of(L, 32, 8, u); return true;
    }
    __device__ __forceinline__ const char* a_base(const Unit& u) const { return A0 + (size_t)u.pm * (256u * DM * 2u); }
    __device__ __forceinline__ const char* b_base(const Unit& u) const { return B0 + (size_t)u.pn * (256u * DM * 2u); }
    __device__ __forceinline__ const char* a_base2(const Unit& u) const { return A1 + (size_t)u.pm * (256u * DM * 2u); }
    __device__ __forceinline__ const char* b_base2(const Unit& u) const { return B1 + (size_t)u.pn * (256u * DM * 2u); }
};
struct SchedPlain {
    const char* A; const char* B; int nM, nN, K, G, c;
    __device__ __forceinline__ bool next(int i, Unit& u) const {
        const int L = i * G + c; if (L >= nM * nN) return false;
        pg8::tile_of(L, nM, nN, u); return true;
    }
    __device__ __forceinline__ const char* a_base(const Unit& u) const { return A + (size_t)u.pm * 256u * (size_t)K * 2u; }
    __device__ __forceinline__ const char* b_base(const Unit& u) const { return B + (size_t)u.pn * 256u * (size_t)K * 2u; }
};

__device__ __forceinline__ void acc_zero(f32x4 (&acc)[2][2][4][2]) {
#pragma unroll
    for (int a = 0; a < 2; ++a)
#pragma unroll
        for (int b = 0; b < 2; ++b)
#pragma unroll
            for (int m = 0; m < 4; ++m)
#pragma unroll
                for (int n = 0; n < 2; ++n) acc[a][b][m][n] = (f32x4){0.f, 0.f, 0.f, 0.f};
}
#define EPI_ZERO_INIT __device__ __forceinline__ void init(f32x4 (&acc)[2][2][4][2], const Unit&, int, int, int, int) const { acc_zero(acc); }
__device__ __forceinline__ void acc_load_f32(f32x4 (&acc)[2][2][4][2], const float* src, const Unit& u, int wr, int wc, int fr, int fq) {
    const int row0 = u.pm * 256 + wr * 64 + fr, col0 = u.pn * 256 + wc * 32 + 4 * fq;
#pragma unroll
    for (int ai = 0; ai < 2; ++ai)
#pragma unroll
        for (int m = 0; m < 4; ++m) { const size_t off = (size_t)(row0 + ai * 128 + m * 16) * DM + col0;
#pragma unroll
            for (int bj = 0; bj < 2; ++bj)
#pragma unroll
                for (int n = 0; n < 2; ++n) acc[ai][bj][m][n] = __builtin_nontemporal_load((const f32x4*)(src + off + bj * 128 + n * 16)); }
}
struct EpiIn {
    static constexpr bool PERM = true;
    bf16_t *Q, *Kb, *Vb, *LX, *LG, *GA, *GL;
    EPI_ZERO_INIT
    __device__ __forceinline__ void operator()(const f32x4 (&acc)[2][2][4][2], const Unit& u, int wr, int wc, int fr, int fq) const {
        const int pn = u.pn; int mode = 0, ldc = DM, colt; bf16_t* base;
        if (pn < 8) { base = Q; colt = pn * 256; }
        else if (pn == 8) { base = Kb; ldc = KVW; colt = 0; }
        else if (pn == 9) { base = Vb; ldc = KVW; colt = 0; }
        else if (pn < 18) { base = LX; colt = (pn - 10) * 256; }
        else if (pn < 26) { base = LG; colt = (pn - 18) * 256; mode = 1; }
        else {
            const int row0g = u.pm * 256 + wr * 64 + fr, ch0 = (pn - 26) * 128 + wc * 32 + 8 * fq;
#pragma unroll
            for (int ai = 0; ai < 2; ++ai)
#pragma unroll
                for (int m = 0; m < 4; ++m) { const size_t off = (size_t)(row0g + ai * 128 + m * 16) * DM + ch0;
                    float sr[8], sl[8];
#pragma unroll
                    for (int e = 0; e < 4; ++e) { const float a0 = fast_sigmoid(acc[ai][0][m][0][e]), a1 = fast_sigmoid(acc[ai][0][m][1][e]); sl[e] = fast_sigmoid(acc[ai][1][m][0][e]); sl[4 + e] = fast_sigmoid(acc[ai][1][m][1][e]);
                        sr[e] = a0 * __builtin_amdgcn_rcpf(fmaxf(sl[e], 1e-30f)); sr[4 + e] = a1 * __builtin_amdgcn_rcpf(fmaxf(sl[4 + e], 1e-30f)); }
                    u32x4 wr4, wl4;
                    wr4.x = cvt_pk_bf16(sr[0], sr[1]); wr4.y = cvt_pk_bf16(sr[2], sr[3]); wr4.z = cvt_pk_bf16(sr[4], sr[5]); wr4.w = cvt_pk_bf16(sr[6], sr[7]);
                    wl4.x = cvt_pk_bf16(sl[0], sl[1]); wl4.y = cvt_pk_bf16(sl[2], sl[3]); wl4.z = cvt_pk_bf16(sl[4], sl[5]); wl4.w = cvt_pk_bf16(sl[6], sl[7]);
                    __builtin_nontemporal_store(wr4, (u32x4*)(GA + off)); __builtin_nontemporal_store(wl4, (u32x4*)(GL + off)); }
            return;
        }
        const int row0 = u.pm * 256 + wr * 64 + fr, col0 = colt + wc * 32 + 8 * fq;
        const bool islx = (pn >= 10 && pn < 18);
#pragma unroll
        for (int ai = 0; ai < 2; ++ai)
#pragma unroll
            for (int m = 0; m < 4; ++m) { const int row = row0 + ai * 128 + m * 16; int orow = row;
                if (islx) orow = (row < MR) ? row + 16 * ((row >> 11) + 1) : row - MR;
                bf16_t* rowp = base + (size_t)orow * ldc + col0;
                const bool metarow = islx && row >= MR; if (metarow && row >= MR + NMETA) continue;
#pragma unroll
                for (int bj = 0; bj < 2; ++bj) { f32x4 v0 = acc[ai][bj][m][0], v1 = acc[ai][bj][m][1];
                    if (mode == 1) {
#pragma unroll
                        for (int e = 0; e < 4; ++e) { v0[e] = gelu_tanh(v0[e]); v1[e] = gelu_tanh(v1[e]); } }
                    else if (mode == 2) {
#pragma unroll
                        for (int e = 0; e < 4; ++e) { v0[e] = fast_sigmoid(v0[e]); v1[e] = fast_sigmoid(v1[e]); } }
                    u32x4 w; w.x = cvt_pk_bf16(v0[0], v0[1]); w.y = cvt_pk_bf16(v0[2], v0[3]); w.z = cvt_pk_bf16(v1[0], v1[1]); w.w = cvt_pk_bf16(v1[2], v1[3]);
                    *(u32x4*)(rowp + bj * 128) = w;
                    if (metarow) { *(u32x4*)(rowp + (size_t)2064 * DM + bj * 128) = w; *(u32x4*)(rowp + (size_t)(2 * 2064) * DM + bj * 128) = w; *(u32x4*)(rowp + (size_t)(3 * 2064) * DM + bj * 128) = w; } } }
    }
};
struct EpiMix {
    static constexpr bool PERM = true;
    const bf16_t *GA, *GL; bf16_t* MIX;
    EPI_ZERO_INIT
    __device__ __forceinline__ void mid(f32x4 (&acc)[2][2][4][2], const Unit& u, int wr, int wc, int fr, int fq) const {
        const int row0 = u.pm * 256 + wr * 64 + fr, col0 = u.pn * 256 + wc * 32 + 8 * fq;
#pragma unroll
        for (int ai = 0; ai < 2; ++ai)
#pragma unroll
            for (int m = 0; m < 4; ++m) { const size_t off = (size_t)(row0 + ai * 128 + m * 16) * DM + col0;
#pragma unroll
                for (int bj = 0; bj < 2; ++bj) { const u32x4 aw = __builtin_nontemporal_load((const u32x4*)(GA + off + bj * 128));
                    const float ra[8] = {bf_lo(aw.x), bf_hi(aw.x), bf_lo(aw.y), bf_hi(aw.y), bf_lo(aw.z), bf_hi(aw.z), bf_lo(aw.w), bf_hi(aw.w)};
#pragma unroll
                    for (int e = 0; e < 4; ++e) { acc[ai][bj][m][0][e] *= ra[e]; acc[ai][bj][m][1][e] *= ra[4 + e]; } } }
    }
    __device__ __forceinline__ void operator()(const f32x4 (&acc)[2][2][4][2], const Unit& u, int wr, int wc, int fr, int fq) const {
        const int row0 = u.pm * 256 + wr * 64 + fr, col0 = u.pn * 256 + wc * 32 + 8 * fq;
#pragma unroll
        for (int ai = 0; ai < 2; ++ai)
#pragma unroll
            for (int m = 0; m < 4; ++m) { const size_t off = (size_t)(row0 + ai * 128 + m * 16) * DM + col0;
#pragma unroll
                for (int bj = 0; bj < 2; ++bj) { const f32x4 a0 = acc[ai][bj][m][0], a1 = acc[ai][bj][m][1];
                    const u32x4 gw = __builtin_nontemporal_load((const u32x4*)(GL + off + bj * 128));
                    u32x4 w; w.x = cvt_pk_bf16(a0[0] * bf_lo(gw.x), a0[1] * bf_hi(gw.x)); w.y = cvt_pk_bf16(a0[2] * bf_lo(gw.y), a0[3] * bf_hi(gw.y));
                    w.z = cvt_pk_bf16(a1[0] * bf_lo(gw.z), a1[1] * bf_hi(gw.z)); w.w = cvt_pk_bf16(a1[2] * bf_lo(gw.w), a1[3] * bf_hi(gw.w));
                    *(u32x4*)(MIX + off + bj * 128) = w; } }
    }
};
struct EpiRes {
    static constexpr bool PERM = false;
    const float* x; const float* g2; float* out; bf16_t* HG; float* rowss; int noatom;
    __device__ __forceinline__ void init(f32x4 (&acc)[2][2][4][2], const Unit& u, int wr, int wc, int fr, int fq) const { acc_load_f32(acc, x, u, wr, wc, fr, fq); }
    __device__ __forceinline__ void operator()(const f32x4 (&acc)[2][2][4][2], const Unit& u, int wr, int wc, int fr, int fq) const {
        const int row0 = u.pm * 256 + wr * 64 + fr, col0 = u.pn * 256 + wc * 32 + 4 * fq;
        f32x4 gv[2][2];
#pragma unroll
        for (int bj = 0; bj < 2; ++bj)
#pragma unroll
            for (int n = 0; n < 2; ++n) gv[bj][n] = *(const f32x4*)(g2 + col0 + bj * 128 + n * 16);
#pragma unroll
        for (int ai = 0; ai < 2; ++ai)
#pragma unroll
            for (int m = 0; m < 4; ++m) { const int row = row0 + ai * 128 + m * 16; const size_t off = (size_t)row * DM + col0; float ss = 0.f;
#pragma unroll
                for (int bj = 0; bj < 2; ++bj)
#pragma unroll
                    for (int n = 0; n < 2; ++n) { const f32x4 h = acc[ai][bj][m][n];
                        __builtin_nontemporal_store(h, (f32x4*)(out + off + bj * 128 + n * 16));
                        ss += (h[0] * h[0] + h[1] * h[1]) + (h[2] * h[2] + h[3] * h[3]);
                        const f32x4 hg = h * gv[bj][n]; u32x2 w; w.x = cvt_pk_bf16(hg[0], hg[1]); w.y = cvt_pk_bf16(hg[2], hg[3]);
                        *(u32x2*)(HG + off + bj * 128 + n * 16) = w; }
                ss += __shfl_xor(ss, 16); ss += __shfl_xor(ss, 32);
                if (fq == 0 && !noatom) atomicAdd(rowss + row, ss); }
    }
};
struct EpiUp {
    static constexpr bool PERM = true;
    const float* rowss; bf16_t* U;
    EPI_ZERO_INIT
    __device__ __forceinline__ void operator()(const f32x4 (&acc)[2][2][4][2], const Unit& u, int wr, int wc, int fr, int fq) const {
        const int row0 = u.pm * 256 + wr * 64 + fr, col0 = u.pn * 256 + wc * 32 + 8 * fq;
#pragma unroll
        for (int ai = 0; ai < 2; ++ai)
#pragma unroll
            for (int m = 0; m < 4; ++m) { const int row = row0 + ai * 128 + m * 16; const float rs = __builtin_amdgcn_rsqf(rowss[row] * (1.0f / DM) + EPS);
                bf16_t* rowp = U + (size_t)row * FF + col0;
#pragma unroll
                for (int bj = 0; bj < 2; ++bj) { f32x4 v0 = acc[ai][bj][m][0] * rs, v1 = acc[ai][bj][m][1] * rs;
#pragma unroll
                    for (int e = 0; e < 4; ++e) { const float a = fmaxf(v0[e], 0.f), b = fmaxf(v1[e], 0.f); v0[e] = a * a; v1[e] = b * b; }
                    u32x4 w; w.x = cvt_pk_bf16(v0[0], v0[1]); w.y = cvt_pk_bf16(v0[2], v0[3]); w.z = cvt_pk_bf16(v1[0], v1[1]); w.w = cvt_pk_bf16(v1[2], v1[3]);
                    *(u32x4*)(rowp + bj * 128) = w; } }
    }
};
struct EpiDown {
    static constexpr bool PERM = false;
    float* out; int nostore;
    __device__ __forceinline__ void init(f32x4 (&acc)[2][2][4][2], const Unit& u, int wr, int wc, int fr, int fq) const { acc_load_f32(acc, out, u, wr, wc, fr, fq); }
    __device__ __forceinline__ void operator()(const f32x4 (&acc)[2][2][4][2], const Unit& u, int wr, int wc, int fr, int fq) const {
        const int row0 = u.pm * 256 + wr * 64 + fr, col0 = u.pn * 256 + wc * 32 + 4 * fq;
#pragma unroll
        for (int ai = 0; ai < 2; ++ai)
#pragma unroll
            for (int m = 0; m < 4; ++m) { const size_t off = (size_t)(row0 + ai * 128 + m * 16) * DM + col0;
#pragma unroll
                for (int bj = 0; bj < 2; ++bj)
#pragma unroll
                    for (int n = 0; n < 2; ++n) { float* p = out + off + bj * 128 + n * 16; if (!nostore) __builtin_nontemporal_store(acc[ai][bj][m][n], (f32x4*)p); } }
    }
};

struct Args {
    const float *x, *meta, *norm1_g, *w_in, *q_norm_g, *k_norm_g, *sinks, *w_o_attn, *conv_w, *conv_b, *lru_wa, *lru_ba, *lru_wi, *lru_bi, *lru_lambda, *w_o_lru, *w_out, *norm2_g, *w_up, *w_down;
    float* out; unsigned char* ws; int ph_lo, ph_hi, flags, pad;
};

__device__ __forceinline__ float wave_sum(float v) {
#pragma unroll
    for (int o = 1; o < 64; o <<= 1) v += __shfl_xor(v, o);
    return v;
}
__device__ __forceinline__ void transpose_load(f32x4 (&v)[16], const float* __restrict__ W, int N, int item, int lane) {
    const int nblk = N >> 6, kb = item / nblk, nb = item - kb * nblk, k0 = kb * 64, n0 = nb * 64;
    const int lr = lane >> 4, lc = (lane & 15) * 4;
    const unsigned off0 = (unsigned)((k0 + lr) * N + n0 + lc), rstep = (unsigned)(4 * N);
#pragma unroll
    for (int i = 0; i < 16; ++i) v[i] = __builtin_nontemporal_load((const f32x4*)(W + (off0 + (unsigned)i * rstep)));
}
template <bool NT = false> __device__ __forceinline__ void transpose_store(const f32x4 (&v)[16], int K, int N, bf16_t* __restrict__ WT, int row_off, LAS float* scr, int item, int lane) {
    const int nblk = N >> 6, kb = item / nblk, nb = item - kb * nblk, k0 = kb * 64, n0 = nb * 64;
    const int lr = lane >> 4, lc = (lane & 15) * 4;
#pragma unroll
    for (int i = 0; i < 16; ++i) { LAS float* s = scr + (4 * i + lr) * 65 + lc; s[0] = v[i][0]; s[1] = v[i][1]; s[2] = v[i][2]; s[3] = v[i][3]; }
    LDS_WAIT(); asm volatile("" ::: "memory");
    const int c = lane & 7, ns = lane >> 3;
    bf16_t* wp = WT + (size_t)(row_off + n0 + ns) * K + k0 + 8 * c; const size_t wstep = (size_t)8 * K;
#pragma unroll
    for (int j = 0; j < 8; ++j) { const LAS float* s = scr + (8 * c) * 65 + ns + 8 * j;
        u32x4 o; o.x = cvt_pk_bf16(s[0 * 65], s[1 * 65]); o.y = cvt_pk_bf16(s[2 * 65], s[3 * 65]); o.z = cvt_pk_bf16(s[4 * 65], s[5 * 65]); o.w = cvt_pk_bf16(s[6 * 65], s[7 * 65]);
        if (NT) __builtin_nontemporal_store(o, (u32x4*)wp); else *(u32x4*)wp = o;
        wp += wstep; asm volatile("" : "+v"(wp)); }
    LDS_WAIT(); asm volatile("" ::: "memory");
}
__device__ __forceinline__ void transpose_item(const float* __restrict__ W, int K, int N, bf16_t* __restrict__ WT, int row_off, LAS float* scr, int item, int lane) {
    f32x4 v[16]; transpose_load(v, W, N, item, lane); transpose_store(v, K, N, WT, row_off, scr, item, lane);
}
__device__ __forceinline__ void rms_row_to_bf16(const float* xrow, const float* g, bf16_t* orow, int lane) {
    const f32x4* xr = (const f32x4*)xrow + lane; const f32x4* gr = (const f32x4*)g + lane;
    f32x4 v[8], gv[8]; float s = 0.f;
#pragma unroll
    for (int j = 0; j < 8; ++j) { v[j] = xr[64 * j]; gv[j] = gr[64 * j]; }
#pragma unroll
    for (int j = 0; j < 8; ++j) s += (v[j][0] * v[j][0] + v[j][1] * v[j][1]) + (v[j][2] * v[j][2] + v[j][3] * v[j][3]);
    const float rs = 1.0f / sqrtf(wave_sum(s) * (1.0f / DM) + EPS);
    u32x2* o8 = (u32x2*)orow + lane;
#pragma unroll
    for (int j = 0; j < 8; ++j) { const f32x4 gg = gv[j]; u32x2 w; w.x = cvt_pk_bf16(v[j][0] * rs * gg[0], v[j][1] * rs * gg[1]); w.y = cvt_pk_bf16(v[j][2] * rs * gg[2], v[j][3] * rs * gg[3]); o8[64 * j] = w; }
}


#define XB_TMO      128
#define XB_XCNT(j)  (256  + 64 * (j))
#define XB_XSUB(j)  (1280 + 64 * (j))
#define XB_XGEN(j)  (2304 + 64 * (j))
#define XB_TOP      3328
#define XB_TOPGEN   3392
#define XCD_BAR_WORDS 3456
#define XB_SPIN_CAP (1u << 18)
__device__ __forceinline__ unsigned xb_ld(unsigned* p)              { return __hip_atomic_load(p, __ATOMIC_RELAXED, __HIP_MEMORY_SCOPE_AGENT); }
__device__ __forceinline__ unsigned xb_add(unsigned* p, unsigned v) { return __hip_atomic_fetch_add(p, v, __ATOMIC_RELAXED, __HIP_MEMORY_SCOPE_AGENT); }
__device__ __forceinline__ unsigned xb_xcc_id() { return (unsigned)__builtin_amdgcn_s_getreg((3 << 11) | 20) & 0xFu; }
#define XB_SPIN(cond, bar) do { unsigned _sp = 0; while (cond) { __builtin_amdgcn_s_sleep(1); \
    if ((++_sp & 255u) == 0u) { if (xb_ld(&(bar)[XB_TMO])) break; if (_sp > XB_SPIN_CAP) { atomicAdd(&(bar)[XB_TMO], 1u); break; } } } } while (0)
struct XcdBarrier { unsigned* bar; unsigned x; volatile LAS unsigned* st; };
__device__ __forceinline__ XcdBarrier xcd_barrier_post(unsigned* bar, volatile LAS unsigned* st) {
    XcdBarrier b; b.bar = bar; b.x = xb_xcc_id(); b.st = st;
    if (threadIdx.x == 0) (void)xb_add(&bar[XB_XCNT(b.x)], 1u);
    return b;
}
__device__ __forceinline__ void xcd_barrier_complete(unsigned* bar, unsigned x, unsigned& nloc, unsigned& nx) {
    const unsigned G = gridDim.x * gridDim.y * gridDim.z;
    unsigned sum, cnt, mine, sp = 0u;
    for (;;) {
        sum = 0u; cnt = 0u; mine = 0u;
#pragma unroll
        for (unsigned j = 0; j < 16; ++j) { const unsigned c = xb_ld(&bar[XB_XCNT(j)]); sum += c; cnt += (c > 0u) ? 1u : 0u; mine = (j == x) ? c : mine; }
        if (sum == G) break;
        __builtin_amdgcn_s_sleep(1);
        if ((++sp & 255u) == 0u) { if (xb_ld(&bar[XB_TMO])) break; if (sp > XB_SPIN_CAP) { atomicAdd(&bar[XB_TMO], 1u); break; } }
    }
    nloc = mine > 0u ? mine : 1u; nx = cnt > 0u ? cnt : 1u;
}
__device__ __forceinline__ void xcd_barrier(const XcdBarrier& b) {
    asm volatile("s_waitcnt vmcnt(0)" ::: "memory");
    __syncthreads();
    if (threadIdx.x == 0) {
        unsigned* bar = b.bar;
        __builtin_amdgcn_s_waitcnt(0);
        unsigned nloc = b.st[0], nx = b.st[1];
        if (nloc == 0u) { xcd_barrier_complete(bar, b.x, nloc, nx); b.st[0] = nloc; b.st[1] = nx; }
        const unsigned old = xb_add(&bar[XB_XSUB(b.x)], 1u);
        const unsigned gen = old / nloc;
        if (old + 1u == (gen + 1u) * nloc) {
            __builtin_amdgcn_fence(__ATOMIC_RELEASE, "agent");
            asm volatile("s_waitcnt vmcnt(0)" ::: "memory");
            const unsigned og = xb_add(&bar[XB_TOP], 1u);
            const unsigned tg = og / nx;
            if (og + 1u == (tg + 1u) * nx) xb_add(&bar[XB_TOPGEN], 1u);
            else XB_SPIN(xb_ld(&bar[XB_TOPGEN]) == tg, bar);
            __builtin_amdgcn_fence(__ATOMIC_ACQUIRE, "agent");
            xb_add(&bar[XB_XGEN(b.x)], 1u);
            asm volatile("s_waitcnt vmcnt(0)" ::: "memory");
        } else {
            XB_SPIN(xb_ld(&bar[XB_XGEN(b.x)]) == gen, bar);
            __builtin_amdgcn_fence(__ATOMIC_ACQUIRE, "agent");
            asm volatile("s_waitcnt vmcnt(0)" ::: "memory");
        }
    }
    __syncthreads();
}

__global__ void __launch_bounds__(NTHREADS, 2) fwd_kernel(Args a) {
    extern __shared__ __attribute__((aligned(16))) unsigned char lds_raw[];
    LAS unsigned char* lds = (LAS unsigned char*)lds_raw;
    const int tid = threadIdx.x, lane = tid & 63, wave = __builtin_amdgcn_readfirstlane(tid >> 6);
    const int G = gridDim.x, bid = blockIdx.x;
    unsigned char* ws = a.ws;
    float* rowss = (float*)(ws + WS_CTL);
    bf16_t* Wt_in = (bf16_t*)(ws + WS_WTIN); bf16_t* XN = (bf16_t*)(ws + WS_XN);
    bf16_t* Wt_up = (bf16_t*)(ws + WS_WTUP); bf16_t* Wt_dn = (bf16_t*)(ws + WS_WTDN);
    bf16_t* Wt_oa = (bf16_t*)(ws + WS_WOA); bf16_t* Wt_ol = (bf16_t*)(ws + WS_WOL); bf16_t* Wt_out = (bf16_t*)(ws + WS_WOUT);
    bf16_t* Wt_a = (bf16_t*)(ws + WS_WA); bf16_t* Wt_i = (bf16_t*)(ws + WS_WI);
    bf16_t* Qb = (bf16_t*)(ws + WS_Q); bf16_t* Kb = (bf16_t*)(ws + WS_K); bf16_t* Vb = (bf16_t*)(ws + WS_V);
    bf16_t* LX = (bf16_t*)(ws + WS_LX); bf16_t* LG = (bf16_t*)(ws + WS_LG); bf16_t* GA = (bf16_t*)(ws + WS_GA); bf16_t* GL = (bf16_t*)(ws + WS_GL);
    bf16_t* MIX = LX; bf16_t* HG = Qb; bf16_t* U = (bf16_t*)(ws + WS_U); bf16_t* Ob = (bf16_t*)(ws + WS_O); bf16_t* REC = (bf16_t*)(ws + WS_REC);
    const int lo = a.ph_lo, hi = a.ph_hi;
#define IN(k) (lo <= (k) && (k) < hi)
    volatile LAS unsigned* bst = (volatile LAS unsigned*)(lds + LDS_BYTES - 16);
    if (tid < 4) bst[tid] = 0u;
    __syncthreads();
    const XcdBarrier xbar = xcd_barrier_post((unsigned*)(ws + WS_BAR) + (a.flags >> 8) * XCD_BAR_WORDS, bst);
#define SEAM(k) do { if (IN(k) && IN((k) + 1)) { xcd_barrier(xbar); } } while (0)
    if (a.ph_lo < 0) cg::this_grid().sync();

    if (IN(0)) {
        LAS float* scr = (LAS float*)(lds + wave * 16640);
        const int gw = bid * NWAVES + wave, NGW = G * NWAVES;
        constexpr int I_IN = 32 * 168, I_LRU = 16 * 16, NITEMS = I_IN + I_LRU;
#define P0_DESC(IT, W_, K_, N_, WT_, RO_, LI_) do { int r_ = (IT) < NITEMS ? (IT) : NITEMS - 1;   \
            if (r_ < I_IN) { const int n0_ = (r_ % (INW / 64)) * 64; int ro_ = 0;     \
                if (n0_ >= 6656) { const int c_ = n0_ - 6656, isgl_ = c_ >> 11, cc_ = c_ & 2047; ro_ = 6656 + (cc_ >> 7) * 256 + isgl_ * 128 + (cc_ & 127) - n0_; } \
                W_ = a.w_in; K_ = DM; N_ = INW; WT_ = Wt_in; RO_ = ro_; LI_ = r_; } \
            else { const int q_ = r_ - I_IN, mat_ = q_ >> 4, which_ = mat_ >> 3, n_ = mat_ & 7; \
                W_ = (which_ ? a.lru_wi : a.lru_wa) + (size_t)n_ * 65536; K_ = 256; N_ = 256; WT_ = which_ ? Wt_i : Wt_a; RO_ = n_ * 256; LI_ = q_ & 15; } } while (0)
        {
            f32x4 va[16], vb[16], vc[16];
            const float* wA; bf16_t* tA; int kA, nA, rA, lA; const float* wB; bf16_t* tB; int kB, nB, rB, lB; const float* wC; bf16_t* tC; int kC, nC, rC, lC;
            P0_DESC(gw, wA, kA, nA, tA, rA, lA); transpose_load(va, wA, nA, lA, lane);
            P0_DESC(gw + NGW, wB, kB, nB, tB, rB, lB); transpose_load(vb, wB, nB, lB, lane);
#pragma unroll 1
            for (int it = gw; it < NITEMS; it += 3 * NGW) {
                P0_DESC(it + 2 * NGW, wC, kC, nC, tC, rC, lC); transpose_load(vc, wC, nC, lC, lane);
                transpose_store(va, kA, nA, tA, rA, scr, lA, lane);
                P0_DESC(it + 3 * NGW, wA, kA, nA, tA, rA, lA); transpose_load(va, wA, nA, lA, lane);
                transpose_store(vb, kB, nB, tB, rB, scr, lB, lane);
                P0_DESC(it + 4 * NGW, wB, kB, nB, tB, rB, lB); transpose_load(vb, wB, nB, lB, lane);
                transpose_store(vc, kC, nC, tC, rC, scr, lC, lane);
            }
        }
#undef P0_DESC
        {
            const f32x4* gr = (const f32x4*)a.norm1_g + lane; f32x4 gv[8];
#pragma unroll
            for (int j = 0; j < 8; ++j) gv[j] = gr[64 * j];
#define P0_ROWSRC(M) ((M) < MR ? a.x + (size_t)(M) * DM : a.meta + (size_t)(((M) < MR + NMETA ? (M) : MR + NMETA - 1) - MR) * DM)
            f32x4 vn[8];
            { const f32x4* xr = (const f32x4*)P0_ROWSRC(gw) + lane;
#pragma unroll
              for (int j = 0; j < 8; ++j) vn[j] = __builtin_nontemporal_load(xr + 64 * j); }
#pragma unroll 1
            for (int m = gw; m < MR + NMETA; m += NGW) {
                f32x4 v[8];
#pragma unroll
                for (int j = 0; j < 8; ++j) v[j] = vn[j];
                { const f32x4* xr = (const f32x4*)P0_ROWSRC(m + NGW) + lane;
#pragma unroll
                  for (int j = 0; j < 8; ++j) vn[j] = __builtin_nontemporal_load(xr + 64 * j); }
                float ssq = 0.f;
#pragma unroll
                for (int j = 0; j < 8; ++j) ssq += (v[j][0] * v[j][0] + v[j][1] * v[j][1]) + (v[j][2] * v[j][2] + v[j][3] * v[j][3]);
                const float rs = 1.0f / sqrtf(wave_sum(ssq) * (1.0f / DM) + EPS);
                u32x2* o8 = (u32x2*)(XN + (size_t)m * DM) + lane;
#pragma unroll
                for (int j = 0; j < 8; ++j) { u32x2 w; w.x = cvt_pk_bf16(v[j][0] * rs * gv[j][0], v[j][1] * rs * gv[j][1]); w.y = cvt_pk_bf16(v[j][2] * rs * gv[j][2], v[j][3] * rs * gv[j][3]); o8[64 * j] = w; }
            }
#undef P0_ROWSRC
            for (int m = MR + NMETA + gw; m < MPAD; m += NGW) { u32x4* o = (u32x4*)(XN + (size_t)m * DM) + lane;
#pragma unroll
                for (int j = 0; j < 4; ++j) o[64 * j] = (u32x4){0u, 0u, 0u, 0u}; }
        }
        for (int i = bid * NTHREADS + tid; i < MR; i += G * NTHREADS) rowss[i] = 0.f;
    }
    SEAM(0);

    if (IN(1)) {
        const int NT_CU = (G >= 128) ? (G * 30) / 256 : 0, NG = G - NT_CU;
        if (bid < NG) {
            SchedIn S{(const char*)XN, (const char*)Wt_in, NG, bid};
            EpiIn E{Qb, Kb, Vb, LX, LG, GA, GL};
            pg8::gemm_phase<EpiIn, SchedIn>(lds, DM, S, E);
        }
        if (bid >= NG || NT_CU == 0) {
            LAS float* scr = (LAS float*)(lds + wave * 16640);
            const int gw = (NT_CU ? bid - NG : bid) * NWAVES + wave, NGW = (NT_CU ? NT_CU : G) * NWAVES;
            constexpr int I_UP = 32 * 128, I_DN = 128 * 32, I_SQ1 = 32 * 32, NIT = I_UP + I_DN + 3 * I_SQ1;
#define P1_DESC(IT, W_, K_, N_, WT_, LI_) do { const int r_ = (IT) < NIT ? (IT) : NIT - 1;   \
                if (r_ < I_UP) { W_ = a.w_up; K_ = DM; N_ = FF; WT_ = Wt_up; LI_ = r_; } \
                else if (r_ < I_UP + I_DN) { W_ = a.w_down; K_ = FF; N_ = DM; WT_ = Wt_dn; LI_ = r_ - I_UP; } \
                else if (r_ < I_UP + I_DN + I_SQ1) { W_ = a.w_o_attn; K_ = DM; N_ = DM; WT_ = Wt_oa; LI_ = r_ - I_UP - I_DN; } \
                else if (r_ < I_UP + I_DN + 2 * I_SQ1) { W_ = a.w_o_lru; K_ = DM; N_ = DM; WT_ = Wt_ol; LI_ = r_ - I_UP - I_DN - I_SQ1; } \
                else { W_ = a.w_out; K_ = DM; N_ = DM; WT_ = Wt_out; LI_ = r_ - I_UP - I_DN - 2 * I_SQ1; } } while (0)
            f32x4 va[16], vb[16];
            const float* wA; bf16_t* tA; int kA, nA, lA; const float* wB; bf16_t* tB; int kB, nB, lB;
            P1_DESC(gw, wA, kA, nA, tA, lA); transpose_load(va, wA, nA, lA, lane);
#pragma unroll 1
            for (int it = gw; it < NIT; it += 2 * NGW) {
                P1_DESC(it + NGW, wB, kB, nB, tB, lB); transpose_load(vb, wB, nB, lB, lane);
                transpose_store<true>(va, kA, nA, tA, 0, scr, lA, lane);
                P1_DESC(it + 2 * NGW, wA, kA, nA, tA, lA); transpose_load(va, wA, nA, lA, lane);
                transpose_store<true>(vb, kB, nB, tB, 0, scr, lB, lane);
            }
#undef P1_DESC
        }
    }
    SEAM(1);

    {
        if (IN(3)) {
            constexpr int KS_STRIDE = 144  , VT_STRIDE = 552  , VT_OFF = 39424;
            const int fr = lane & 15, fq = lane >> 4;
            for (int unit = bid; unit < 256; unit += G) {
                const int b = unit >> 6, qb = (unit >> 2) & 15, g = unit & 3;
                {
                    const int ch = tid & 7;
                    float gk[8];
#pragma unroll
                    for (int e = 0; e < 8; ++e) gk[e] = a.k_norm_g[ch * 8 + e];
                    u32x4 kws[5], vws[5];
#pragma unroll
                    for (int it = 0; it < 5; ++it) {
                        const int key = (it * NTHREADS + tid) >> 3;
                        bool ld = key < 272; int row = 0;
                        if (key < 16) row = MR + key;
                        else { const int ik = key - 16; row = b * SEQ + qb * 128 - 128 + ik; if (qb == 0 && ik < 128) ld = false; }
                        kws[it] = (u32x4){0u, 0u, 0u, 0u}; vws[it] = (u32x4){0u, 0u, 0u, 0u};
                        if (ld) { kws[it] = *(const u32x4*)(Kb + (size_t)row * KVW + g * 64 + ch * 8); vws[it] = *(const u32x4*)(Vb + (size_t)row * KVW + g * 64 + ch * 8); }
                    }
#pragma unroll
                    for (int it = 0; it < 5; ++it) {
                        const int key = (it * NTHREADS + tid) >> 3;
                        const u32x4 kw = kws[it], vw = vws[it];
                        float kf[8] = {bf_lo(kw.x), bf_hi(kw.x), bf_lo(kw.y), bf_hi(kw.y), bf_lo(kw.z), bf_hi(kw.z), bf_lo(kw.w), bf_hi(kw.w)};
                        float ss = 0.f;
#pragma unroll
                        for (int e = 0; e < 8; ++e) ss += kf[e] * kf[e];
                        ss += __shfl_xor(ss, 1); ss += __shfl_xor(ss, 2); ss += __shfl_xor(ss, 4);
                        const float sc = 1.0f / sqrtf(ss * (1.0f / 64.0f) + EPS);
                        if (key < 272) {
                            u32x4 o; o.x = cvt_pk_bf16(kf[0] * sc * gk[0], kf[1] * sc * gk[1]); o.y = cvt_pk_bf16(kf[2] * sc * gk[2], kf[3] * sc * gk[3]);
                            o.z = cvt_pk_bf16(kf[4] * sc * gk[4], kf[5] * sc * gk[5]); o.w = cvt_pk_bf16(kf[6] * sc * gk[6], kf[7] * sc * gk[7]);
                            *(LAS u32x4*)(lds + key * KS_STRIDE + ch * 16) = o;
                            LAS bf16_t* vt = (LAS bf16_t*)(lds + VT_OFF + (ch * 8) * VT_STRIDE + key * 2);
                            vt[0 * (VT_STRIDE / 2)] = (bf16_t)(vw.x & 0xffffu); vt[1 * (VT_STRIDE / 2)] = (bf16_t)(vw.x >> 16);
                            vt[2 * (VT_STRIDE / 2)] = (bf16_t)(vw.y & 0xffffu); vt[3 * (VT_STRIDE / 2)] = (bf16_t)(vw.y >> 16);
                            vt[4 * (VT_STRIDE / 2)] = (bf16_t)(vw.z & 0xffffu); vt[5 * (VT_STRIDE / 2)] = (bf16_t)(vw.z >> 16);
                            vt[6 * (VT_STRIDE / 2)] = (bf16_t)(vw.w & 0xffffu); vt[7 * (VT_STRIDE / 2)] = (bf16_t)(vw.w >> 16);
                        }
                    }
                }
                __syncthreads();
                const int h = g * 8 + wave;
                const float sinkl = a.sinks[h] * LOG2E;
                float gq[16];
#pragma unroll
                for (int e = 0; e < 8; ++e) { gq[e] = a.q_norm_g[8 * fq + e]; gq[8 + e] = a.q_norm_g[32 + 8 * fq + e]; }
                u32x4 q0n, q1n;
                { const bf16_t* qp0 = Qb + (size_t)(b * SEQ + qb * 128 + fr) * DM + h * 64; q0n = *(const u32x4*)(qp0 + 8 * fq); q1n = *(const u32x4*)(qp0 + 32 + 8 * fq); }
#pragma unroll 1
                for (int mt = 0; mt < 8; ++mt) {
                    const size_t qrow = (size_t)(b * SEQ + qb * 128 + mt * 16 + fr);
                    const u32x4 q0 = q0n, q1 = q1n;
                    { const bf16_t* qpn = Qb + (qrow + (mt < 7 ? 16 : 0)) * DM + h * 64; q0n = *(const u32x4*)(qpn + 8 * fq); q1n = *(const u32x4*)(qpn + 32 + 8 * fq); }
                    float qf[16] = {bf_lo(q0.x), bf_hi(q0.x), bf_lo(q0.y), bf_hi(q0.y), bf_lo(q0.z), bf_hi(q0.z), bf_lo(q0.w), bf_hi(q0.w),
                                    bf_lo(q1.x), bf_hi(q1.x), bf_lo(q1.y), bf_hi(q1.y), bf_lo(q1.z), bf_hi(q1.z), bf_lo(q1.w), bf_hi(q1.w)};
                    float ss = 0.f;
#pragma unroll
                    for (int e = 0; e < 16; ++e) ss += qf[e] * qf[e];
                    ss += __shfl_xor(ss, 16); ss += __shfl_xor(ss, 32);
                    const float sc = (0.125f * LOG2E) / sqrtf(ss * (1.0f / 64.0f) + EPS);
                    u32x4 qa, qc;
                    qa.x = cvt_pk_bf16(qf[0] * sc * gq[0], qf[1] * sc * gq[1]); qa.y = cvt_pk_bf16(qf[2] * sc * gq[2], qf[3] * sc * gq[3]);
                    qa.z = cvt_pk_bf16(qf[4] * sc * gq[4], qf[5] * sc * gq[5]); qa.w = cvt_pk_bf16(qf[6] * sc * gq[6], qf[7] * sc * gq[7]);
                    qc.x = cvt_pk_bf16(qf[8] * sc * gq[8], qf[9] * sc * gq[9]); qc.y = cvt_pk_bf16(qf[10] * sc * gq[10], qf[11] * sc * gq[11]);
                    qc.z = cvt_pk_bf16(qf[12] * sc * gq[12], qf[13] * sc * gq[13]); qc.w = cvt_pk_bf16(qf[14] * sc * gq[14], qf[15] * sc * gq[15]);
                    const bf16x8 qfr0 = __builtin_bit_cast(bf16x8, qa), qfr1 = __builtin_bit_cast(bf16x8, qc);
                    f32x4 st[10];
#pragma unroll
                    for (int j = 0; j < 10; ++j) {
                        const int kbase = (j == 0) ? 0 : 16 + 16 * (mt + j - 1);
                        const LAS unsigned char* kp = lds + (kbase + fr) * KS_STRIDE + fq * 16;
                        const bf16x8 k0 = *(const LAS bf16x8*)(kp), k1 = *(const LAS bf16x8*)(kp + 64);
                        f32x4 s = (f32x4){0.f, 0.f, 0.f, 0.f};
                        s = __builtin_amdgcn_mfma_f32_16x16x32_bf16(k0, qfr0, s, 0, 0, 0);
                        s = __builtin_amdgcn_mfma_f32_16x16x32_bf16(k1, qfr1, s, 0, 0, 0);
                        st[j] = s;
                    }
#pragma unroll
                    for (int r = 0; r < 4; ++r) { const int d1 = 4 * fq + r - fr; st[1][r] = (d1 >= 1) ? st[1][r] : -1e30f; st[9][r] = (d1 <= 0) ? st[9][r] : -1e30f; }
                    if (qb == 0) {
#pragma unroll
                        for (int j = 1; j < 10; ++j)
#pragma unroll
                            for (int r = 0; r < 4; ++r) st[j][r] = ((16 * (mt + j - 1) + 4 * fq + r) < 128) ? -1e30f : st[j][r];
                    }
                    float mx = sinkl;
#pragma unroll
                    for (int j = 0; j < 10; ++j) mx = fmaxf(fmaxf(mx, fmaxf(st[j][0], st[j][1])), fmaxf(st[j][2], st[j][3]));
                    mx = fmaxf(mx, __shfl_xor(mx, 16)); mx = fmaxf(mx, __shfl_xor(mx, 32));
                    float den = 0.f;
#pragma unroll
                    for (int j = 0; j < 10; ++j)
#pragma unroll
                        for (int r = 0; r < 4; ++r) { const float p = __builtin_amdgcn_exp2f(st[j][r] - mx); st[j][r] = p; den += p; }
                    den += __shfl_xor(den, 16); den += __shfl_xor(den, 32);
                    den += __builtin_amdgcn_exp2f(sinkl - mx);
                    const float rden = 1.0f / den;
                    f32x4 o[4];
#pragma unroll
                    for (int dt = 0; dt < 4; ++dt) o[dt] = (f32x4){0.f, 0.f, 0.f, 0.f};
#pragma unroll
                    for (int kp = 0; kp < 5; ++kp) {
                        u32x4 pw; pw.x = cvt_pk_bf16(st[2 * kp][0], st[2 * kp][1]); pw.y = cvt_pk_bf16(st[2 * kp][2], st[2 * kp][3]);
                        pw.z = cvt_pk_bf16(st[2 * kp + 1][0], st[2 * kp + 1][1]); pw.w = cvt_pk_bf16(st[2 * kp + 1][2], st[2 * kp + 1][3]);
                        const bf16x8 pfr = __builtin_bit_cast(bf16x8, pw);
                        const int kb0 = (kp == 0) ? 0 : 16 + 16 * (mt + 2 * kp - 1), kb1 = 16 + 16 * (mt + 2 * kp);
#pragma unroll
                        for (int dt = 0; dt < 4; ++dt) {
                            const LAS unsigned char* vp = lds + VT_OFF + (16 * dt + fr) * VT_STRIDE + 8 * fq;
                            const u32x2 va = *(const LAS u32x2*)(vp + 2 * kb0), vb = *(const LAS u32x2*)(vp + 2 * kb1);
                            const u32x4 vv = (u32x4){va.x, va.y, vb.x, vb.y};
                            o[dt] = __builtin_amdgcn_mfma_f32_16x16x32_bf16(__builtin_bit_cast(bf16x8, vv), pfr, o[dt], 0, 0, 0);
                        }
                    }
#pragma unroll
                    for (int dt = 0; dt < 4; ++dt) { u32x2 w; w.x = cvt_pk_bf16(o[dt][0] * rden, o[dt][1] * rden); w.y = cvt_pk_bf16(o[dt][2] * rden, o[dt][3] * rden);
                        *(u32x2*)(Ob + qrow * DM + h * 64 + 16 * dt + 4 * fq) = w; }
                }
                __syncthreads();
            }
        }
        if (IN(4)) {
            constexpr int AT_STRIDE = 528  , WL_OFF = 67584, AB_OFF = 101376, BB_OFF = 117888, SEG_OFF = 134400, CARRY_OFF = 138496, GC_OFF = 138752, CW_OFF = 139136, ABS = 129  ;
            static_assert(CW_OFF + 5120 <= LDS_BYTES, "LRU LDS map");
            const int fr = lane & 15, fq = lane >> 4;
            for (int item = bid; item < 256; item += G) {
                const int b = item >> 6, n = (item >> 3) & 7, d0 = (item & 7) * 32, cb = n * 256 + d0;
                const int cg8 = tid & 31, seg = tid >> 5; const int cch = n * 256 + cg8 * 8;
                {
                    u32x4 wtmp[4]; float ctmp[3], gtmp[3];
#pragma unroll
                    for (int k = 0; k < 4; ++k) { const int i = tid + k * NTHREADS, gate = i >> 10, dd = (i >> 5) & 31, kc = i & 31;
                        wtmp[k] = *(const u32x4*)((gate ? Wt_i : Wt_a) + (size_t)(n * 256 + d0 + dd) * 256 + kc * 8); }
#pragma unroll
                    for (int k = 0; k < 3; ++k) { const int i = tid + k * NTHREADS, ic = i < 1280 ? i : 1279, tp = ic >> 8, c = ic & 255;
                        const float* src = (tp < 4) ? a.conv_w + tp * DM + n * 256 + c : a.conv_b + n * 256 + c; ctmp[k] = *src; }
                    { const int ch = cb + (tid & 31); gtmp[0] = a.lru_lambda[ch]; gtmp[1] = a.lru_ba[ch]; gtmp[2] = a.lru_bi[ch]; }
#pragma unroll
                    for (int k = 0; k < 4; ++k) { const int i = tid + k * NTHREADS, gate = i >> 10, dd = (i >> 5) & 31, kc = i & 31;
                        *(LAS u32x4*)(lds + WL_OFF + (gate * 32 + dd) * AT_STRIDE + kc * 16) = wtmp[k]; }
#pragma unroll
                    for (int k = 0; k < 3; ++k) { const int i = tid + k * NTHREADS; if (i < 1280) ((LAS float*)(lds + CW_OFF))[i] = ctmp[k]; }
                    if (tid < 32) { const float lam = gtmp[0];
                        ((LAS float*)(lds + GC_OFF))[tid] = (lam > 15.f) ? __expf(-lam) : log1pf(__expf(-lam)); ((LAS float*)(lds + GC_OFF))[32 + tid] = gtmp[1]; ((LAS float*)(lds + GC_OFF))[64 + tid] = gtmp[2]; }
                    if (tid < 64) ((LAS float*)(lds + CARRY_OFF))[tid] = 0.f;
                }
                __syncthreads();
                const u32x4 zero4 = (u32x4){0u, 0u, 0u, 0u};
                const int sch0 = tid & 31, seg0 = seg, fr0 = fr, fq0 = fq, cg80 = cg8;
#define LRU_LOAD_ROWS(TI) do { const bf16_t* base_ = LX + ((long)(b * 2064 + ((TI) == 0 ? 0 : 16 + ((TI) - 1) * 128) + seg * 8 - 3)) * DM + cch; \
                    _Pragma("unroll") for (int q_ = 0; q_ < 11; ++q_) { const bool ok_ = !((TI) == 0 && seg == 0 && q_ < 3); lxr[q_] = zero4; if (ok_) lxr[q_] = *(const u32x4*)(base_ + (long)q_ * DM); } } while (0)
                u32x4 lxr[11];
                LRU_LOAD_ROWS(0);
#pragma unroll 1
                for (int ti = 0; ti < 17; ++ti) {
                    int seg = seg0, sch = sch0, fr = fr0, fq = fq0, cg8 = cg80;
                    asm volatile("" : "+v"(seg), "+v"(sch), "+v"(fr), "+v"(fq), "+v"(cg8));
                    {
                        f32x2 win[3][4], cw[4][4], cbias[4];
#pragma unroll
                        for (int p = 0; p < 4; ++p) { win[0][p] = (f32x2){0.f, 0.f}; win[1][p] = (f32x2){0.f, 0.f}; win[2][p] = (f32x2){0.f, 0.f}; }
#pragma unroll
                        for (int tp = 0; tp < 5; ++tp) { const f32x4 c0 = *(const LAS f32x4*)(lds + CW_OFF + (tp * 256 + cg8 * 8) * 4), c1 = *(const LAS f32x4*)(lds + CW_OFF + (tp * 256 + cg8 * 8 + 4) * 4);
                            if (tp < 4) { cw[tp & 3][0] = (f32x2){c0[0], c0[1]}; cw[tp & 3][1] = (f32x2){c0[2], c0[3]}; cw[tp & 3][2] = (f32x2){c1[0], c1[1]}; cw[tp & 3][3] = (f32x2){c1[2], c1[3]}; }
                            else { cbias[0] = (f32x2){c0[0], c0[1]}; cbias[1] = (f32x2){c0[2], c0[3]}; cbias[2] = (f32x2){c1[0], c1[1]}; cbias[3] = (f32x2){c1[2], c1[3]}; } }
#pragma unroll
                        for (int q = 0; q < 11; ++q) {
                            const u32x4 w = lxr[q];
                            const f32x2 cur[4] = {(f32x2){bf_lo(w.x), bf_hi(w.x)}, (f32x2){bf_lo(w.y), bf_hi(w.y)}, (f32x2){bf_lo(w.z), bf_hi(w.z)}, (f32x2){bf_lo(w.w), bf_hi(w.w)}};
                            if (q >= 3) {
                                f32x2 y[4];
#pragma unroll
                                for (int p = 0; p < 4; ++p) y[p] = __builtin_elementwise_fma(cur[p], cw[3][p], __builtin_elementwise_fma(win[2][p], cw[2][p], __builtin_elementwise_fma(win[1][p], cw[1][p], __builtin_elementwise_fma(win[0][p], cw[0][p], cbias[p]))));
                                u32x4 o; o.x = cvt_pk_bf16(y[0][0], y[0][1]); o.y = cvt_pk_bf16(y[1][0], y[1][1]); o.z = cvt_pk_bf16(y[2][0], y[2][1]); o.w = cvt_pk_bf16(y[3][0], y[3][1]);
                                *(LAS u32x4*)(lds + (seg * 8 + q - 3) * AT_STRIDE + cg8 * 16) = o;
                            }
#pragma unroll
                            for (int p = 0; p < 4; ++p) { win[0][p] = win[1][p]; win[1][p] = win[2][p]; win[2][p] = cur[p]; }
                        }
                    }
                    const size_t row0 = (size_t)(b * SEQ + (ti > 0 ? ti - 1 : 0) * 128 + 8 * seg);
                    unsigned lgv[8];
                    { const bf16_t* lgp = LG + row0 * DM + cb + sch;
#pragma unroll
                      for (int j = 0; j < 8; ++j) lgv[j] = lgp[(size_t)j * DM]; }
                    { const int tn = ti < 16 ? ti + 1 : 16; LRU_LOAD_ROWS(tn); }
                    WG_BAR();
                    {
                        f32x4 acc[2][2];
#pragma unroll
                        for (int gt = 0; gt < 2; ++gt)
#pragma unroll
                            for (int nt = 0; nt < 2; ++nt) acc[gt][nt] = (f32x4){0.f, 0.f, 0.f, 0.f};
#pragma unroll
                        for (int ks = 0; ks < 8; ++ks) {
                            const bf16x8 af = *(const LAS bf16x8*)(lds + (16 * wave + fr) * AT_STRIDE + ks * 64 + fq * 16);
#pragma unroll
                            for (int gt = 0; gt < 2; ++gt)
#pragma unroll
                                for (int nt = 0; nt < 2; ++nt) {
                                    const bf16x8 wf = *(const LAS bf16x8*)(lds + WL_OFF + (gt * 32 + 16 * nt + fr) * AT_STRIDE + ks * 64 + fq * 16);
                                    acc[gt][nt] = __builtin_amdgcn_mfma_f32_16x16x32_bf16(wf, af, acc[gt][nt], 0, 0, 0);
                                }
                        }
                        const int tk = 16 * wave + fr;
#pragma unroll
                        for (int nt = 0; nt < 2; ++nt)
#pragma unroll
                            for (int r = 0; r < 4; ++r) {
                                const int ch = 16 * nt + 4 * fq + r;
                                const float splv = ((LAS float*)(lds + GC_OFF))[ch], bavv = ((LAS float*)(lds + GC_OFF))[32 + ch], bivv = ((LAS float*)(lds + GC_OFF))[64 + ch];
                                const float rg = fast_sigmoid(acc[0][nt][r] + bavv), ig = fast_sigmoid(acc[1][nt][r] + bivv);
                                const float la = -8.0f * rg * splv;
                                const float av = __builtin_amdgcn_exp2f(la * LOG2E);
                                const float t2 = 2.0f * la;
                                const float m2s = -t2 * (1.0f + t2 * (0.5f + t2 * (0.16666667f + t2 * (0.041666668f + t2 * (0.0083333338f + t2 * 0.0013888889f)))));
                                const float m2 = (t2 > -0.25f) ? m2s : (1.0f - av * av);
                                float mult = __builtin_amdgcn_sqrtf(fmaxf(m2, 0.f));
                                if (ti == 0 && tk == 0) mult = 1.0f;
                                const float xv = bf2f(*(const LAS bf16_t*)(lds + tk * AT_STRIDE + (d0 + ch) * 2));
                                ((LAS float*)(lds + AB_OFF))[ch * ABS + tk] = av;
                                ((LAS float*)(lds + BB_OFF))[ch * ABS + tk] = mult * ig * xv;
                            }
                    }
                    WG_BAR();
                    {
                        float A = 1.f, H = 0.f;
#pragma unroll
                        for (int j = 0; j < 8; ++j) { const float av = ((LAS float*)(lds + AB_OFF))[sch * ABS + 8 * seg + j], bv = ((LAS float*)(lds + BB_OFF))[sch * ABS + 8 * seg + j]; H = av * H + bv; A *= av; }
                        ((LAS f32x2*)(lds + SEG_OFF))[seg * 32 + sch] = (f32x2){A, H};
                    }
                    WG_BAR();
                    {
#pragma unroll
                        for (int j = 0; j < 8; ++j) asm volatile("" : "+v"(lgv[j]));
                        float hst = ((LAS float*)(lds + CARRY_OFF))[(ti & 1) * 32 + sch];
                        f32x2 shs[15];
#pragma unroll
                        for (int s2 = 0; s2 < 15; ++s2) shs[s2] = ((LAS f32x2*)(lds + SEG_OFF))[s2 * 32 + sch];
#pragma unroll
                        for (int s2 = 0; s2 < 15; ++s2) hst = (s2 < seg) ? shs[s2].x * hst + shs[s2].y : hst;
#pragma unroll
                        for (int j = 0; j < 8; ++j) { const float av = ((LAS float*)(lds + AB_OFF))[sch * ABS + 8 * seg + j], bv = ((LAS float*)(lds + BB_OFF))[sch * ABS + 8 * seg + j]; hst = av * hst + bv;
                            if (ti > 0) REC[(row0 + j) * DM + cb + sch] = (bf16_t)(cvt_pk_bf16(__uint_as_float(lgv[j] << 16) * hst, 0.f) & 0xffffu); }
                        const int lastseg = (ti == 0) ? 1 : 15;
                        if (seg == lastseg) ((LAS float*)(lds + CARRY_OFF))[((ti + 1) & 1) * 32 + sch] = hst;
                    }
                }
#undef LRU_LOAD_ROWS
                __syncthreads();
            }
        }
    }
    SEAM(4);

    if (IN(5)) {
        SchedMix S{(const char*)Ob, (const char*)REC, (const char*)Wt_oa, (const char*)Wt_ol, G, bid};
        EpiMix E{GA, GL, MIX};
        pg8::gemm_phase<EpiMix, SchedMix, true>(lds, 2 * DM, S, E);
    }
    SEAM(5);

    if (IN(6)) {
        SchedPlain S{(const char*)MIX, (const char*)Wt_out, 32, 8, DM, G, bid};
        EpiRes E{a.x, a.norm2_g, a.out, HG, rowss, a.flags & 1};
        pg8::gemm_phase<EpiRes, SchedPlain>(lds, DM, S, E);
    }
    SEAM(6);

    if (IN(7)) {
        SchedPlain S{(const char*)HG, (const char*)Wt_up, 32, 32, DM, G, bid};
        EpiUp E{rowss, U};
        pg8::gemm_phase<EpiUp, SchedPlain>(lds, DM, S, E);
    }
    SEAM(7);

    if (IN(8)) {
        SchedPlain S{(const char*)U, (const char*)Wt_dn, 32, 8, FF, G, bid};
        EpiDown E{a.out, a.flags & 2};
        pg8::gemm_phase<EpiDown, SchedPlain>(lds, FF, S, E);
    }
#undef IN
#undef SEAM
}

extern "C" void kernel_launch(void* const* d_in, const int* in_sizes, int n_in, void* d_out, int out_size, void* d_ws, size_t ws_size, hipStream_t stream) {
    static int grid = 0;
    if (grid == 0) {
        if (n_in != 20 || ws_size < WS_END) { fprintf(stderr, "kernel_launch: unexpected inputs (n_in %d, ws %zu)\n", n_in, ws_size); grid = -1; return; }
        int dev = 0, cus = 0, per_cu = 0;
        hipGetDevice(&dev);
        hipDeviceGetAttribute(&cus, hipDeviceAttributeMultiprocessorCount, dev);
        if (hipFuncSetAttribute((const void*)fwd_kernel, hipFuncAttributeMaxDynamicSharedMemorySize, LDS_BYTES) != hipSuccess) { fprintf(stderr, "kernel_launch: hipFuncSetAttribute failed\n"); grid = -1; return; }
        if (hipOccupancyMaxActiveBlocksPerMultiprocessor(&per_cu, (const void*)fwd_kernel, NTHREADS, LDS_BYTES) != hipSuccess || per_cu < 1) { fprintf(stderr, "kernel_launch: occupancy query says %d\n", per_cu); per_cu = 1; }
        (void)hipGetLastError();
        grid = cus * per_cu;
    }
    if (grid < 0) return;
    Args a{};
    a.x = (const float*)d_in[0]; a.meta = (const float*)d_in[1]; a.norm1_g = (const float*)d_in[2]; a.w_in = (const float*)d_in[3];
    a.q_norm_g = (const float*)d_in[4]; a.k_norm_g = (const float*)d_in[5]; a.sinks = (const float*)d_in[6]; a.w_o_attn = (const float*)d_in[7];
    a.conv_w = (const float*)d_in[8]; a.conv_b = (const float*)d_in[9]; a.lru_wa = (const float*)d_in[10]; a.lru_ba = (const float*)d_in[11];
    a.lru_wi = (const float*)d_in[12]; a.lru_bi = (const float*)d_in[13]; a.lru_lambda = (const float*)d_in[14]; a.w_o_lru = (const float*)d_in[15];
    a.w_out = (const float*)d_in[16]; a.norm2_g = (const float*)d_in[17]; a.w_up = (const float*)d_in[18]; a.w_down = (const float*)d_in[19];
    a.out = (float*)d_out; a.ws = (unsigned char*)d_ws;
    if (hipMemsetAsync((unsigned char*)d_ws + WS_BAR, 0, WS_BAR_BYTES, stream) != hipSuccess) { fprintf(stderr, "kernel_launch: memset of the barrier words failed\n"); return; }
#if MK_MULTI
    for (int ph = 0; ph < 9; ++ph) {
        a.ph_lo = ph; a.ph_hi = ph + 1; a.flags = 0;
        void* args[] = {&a};
        hipError_t e = hipLaunchCooperativeKernel((const void*)fwd_kernel, dim3(grid), dim3(NTHREADS), args, LDS_BYTES, stream);
        if (e != hipSuccess) { fprintf(stderr, "cooperative launch (phase %d) failed: %s (grid %d)\n", ph, hipGetErrorString(e), grid); break; }
    }
#elif PROBE_DUP >= 0
    for (int li = 0; li < 2; ++li) {
        a.ph_lo = li ? PROBE_DUP : 0; a.ph_hi = li ? 9 : PROBE_DUP + 1; a.flags = (li << 8) | (li ? 0 : (PROBE_DUP == 6 ? 1 : (PROBE_DUP == 8 ? 2 : 0)));
        void* args[] = {&a};
        hipError_t e = hipLaunchCooperativeKernel((const void*)fwd_kernel, dim3(grid), dim3(NTHREADS), args, LDS_BYTES, stream);
        if (e != hipSuccess) { fprintf(stderr, "cooperative launch failed: %s (grid %d)\n", hipGetErrorString(e), grid); break; }
    }
#else
    a.ph_lo = 0; a.ph_hi = 9;
    void* args[] = {&a};
    hipError_t e = hipLaunchCooperativeKernel((const void*)fwd_kernel, dim3(grid), dim3(NTHREADS), args, LDS_BYTES, stream);
    if (e != hipSuccess) fprintf(stderr, "cooperative launch failed: %s (grid %d)\n", hipGetErrorString(e), grid);
#endif
}
```

```cpp
#include <hip/hip_runtime.h>
#include <hip/hip_cooperative_groups.h>
#include <cstdio>
#include <cstdint>
namespace cg = cooperative_groups;

#ifndef MK_MULTI
#define MK_MULTI 0
#endif

#ifndef PROBE_DUP
#define PROBE_DUP -1
#endif

#define LAS __attribute__((address_space(3)))
typedef unsigned short bf16_t;
typedef short bf16x8 __attribute__((ext_vector_type(8)));
typedef float f32x4 __attribute__((ext_vector_type(4)));
typedef float f32x2 __attribute__((ext_vector_type(2)));
typedef unsigned u32x4 __attribute__((ext_vector_type(4)));
typedef unsigned u32x2 __attribute__((ext_vector_type(2)));

constexpr int DM = 2048, NBATCH = 4, SEQ = 2048, MR = NBATCH * SEQ  , NMETA = 16, MPAD = 8448  ;
constexpr int INW = 10752, FF = 8192, KVW = 256;
constexpr float EPS = 1e-6f;
constexpr float LOG2E = 1.4426950408889634f;
constexpr int NTHREADS = 512, NWAVES = 8;
constexpr int LDS_BYTES = 147456;

constexpr size_t MiB = 1u << 20;
constexpr size_t WS_CTL = 0;
constexpr size_t WS_BAR = 65536, WS_BAR_BYTES = 65536;
constexpr size_t WS_R1 = 1 * MiB;
constexpr size_t WS_WTIN = WS_R1, WS_XN = WS_R1 + 42 * MiB;
constexpr size_t WS_WTUP = 272 * MiB, WS_WTDN = 304 * MiB;
constexpr size_t WS_WOA = 76 * MiB, WS_WOL = 84 * MiB, WS_WOUT = 92 * MiB, WS_WA = 100 * MiB, WS_WI = 101 * MiB;
constexpr size_t WS_Q = 102 * MiB;
constexpr size_t WS_K = 134 * MiB, WS_V = 134 * MiB + 4608 * 1024;
constexpr size_t WS_LX = 143 * MiB;
constexpr size_t WS_LG = 176 * MiB;
constexpr size_t WS_GA = 208 * MiB, WS_GL = 240 * MiB;
constexpr size_t WS_U = 143 * MiB;
#if PROBE_DUP == 3 || PROBE_DUP == 4
constexpr size_t WS_O = WS_R1, WS_REC = WS_R1 + 32 * MiB;
#else
constexpr size_t WS_O = WS_Q, WS_REC = WS_LG;
#endif
constexpr size_t WS_END = 336 * MiB;

typedef __bf16 bf16x2_t __attribute__((ext_vector_type(2)));
__device__ __forceinline__ unsigned cvt_pk_bf16(float lo, float hi) { const f32x2 v = {lo, hi}; const bf16x2_t b = __builtin_convertvector(v, bf16x2_t); return __builtin_bit_cast(unsigned, b); }
__device__ __forceinline__ float bf_lo(unsigned w) { return __uint_as_float(w << 16); }
__device__ __forceinline__ float bf_hi(unsigned w) { return __uint_as_float(w & 0xffff0000u); }
__device__ __forceinline__ float bf2f(bf16_t u) { return __uint_as_float((unsigned)u << 16); }
__device__ __forceinline__ float fast_sigmoid(float x) { return __builtin_amdgcn_rcpf(1.0f + __builtin_amdgcn_exp2f(-x * LOG2E)); }
__device__ __forceinline__ float gelu_tanh(float x) { const float y = 0.7978845608028654f * (x + 0.044715f * x * x * x); return x * __builtin_amdgcn_rcpf(1.0f + __builtin_amdgcn_exp2f(-2.0f * LOG2E * y)); }
#define LDS_WAIT() asm volatile("s_waitcnt lgkmcnt(0)" ::: "memory")
#define WG_BAR() do { asm volatile("s_waitcnt lgkmcnt(0)" ::: "memory"); __builtin_amdgcn_s_barrier(); asm volatile("" ::: "memory"); } while (0)

namespace pg8 {
constexpr int BM = 256, BK = 64, HALF = 128, HTB = HALF * BK * 2, STAGE_BYTES = 8 * HTB, NXCD = 8, WGM = 8;
__host__ __device__ __forceinline__ int lds_byte(int r, int c) { const int st = (r >> 4) * 2 + (c >> 5), rr = r & 15, cc = c & 31, ob = rr * 64 + cc * 2; return st * 1024 + (ob ^ (((ob >> 9) & 1) << 5)); }
__host__ __device__ __forceinline__ void stage_rc(int b, int& R, int& C) { const int st = b / 1024, sb = b % 1024, swz = sb ^ (((sb >> 9) & 1) << 5); R = (st >> 1) * 16 + swz / 64; C = (st & 1) * 32 + (swz % 64) / 2; }
__host__ __device__ __forceinline__ int perm32(int rho) { const int n = rho >> 4, i = rho & 15; return 8 * (i >> 2) + 4 * n + (i & 3); }

struct Unit { int pm, pn, sub; };

__device__ __forceinline__ void tile_of(int wgid, int nM, int nN, Unit& u) {
    const int nwg = nM * nN;
    { const int q = nwg / NXCD, r = nwg % NXCD, xcd = wgid % NXCD, off = wgid / NXCD; wgid = (xcd < r ? xcd * (q + 1) : r * (q + 1) + (xcd - r) * q) + off; }
    const int nig = WGM * nN, gid = wgid / nig, fm = gid * WGM, gsz = (nM - fm) < WGM ? (nM - fm) : WGM;
    u.pm = fm + ((wgid % nig) % gsz); u.pn = (wgid % nig) / gsz; u.sub = 0;
}

template <class Epi, class Sched, bool SPLITK = false>
__device__ __forceinline__ void gemm_phase(LAS unsigned char* lds, const int K, const Sched& S, const Epi& E) {
    const int tid = threadIdx.x, wid = __builtin_amdgcn_readfirstlane(tid >> 6), lane = tid & 63, wr = wid >> 2, wc = wid & 3, fr = lane & 15, fq = lane >> 4;
    const int nt = K / BK, nth = nt / 2, ld = SPLITK ? K / 2 : K;
    unsigned voffA[2], voffB[2];
#pragma unroll
    for (int i = 0; i < 2; ++i) { int R, C; stage_rc(tid * 16 + i * 8192, R, C); const int Rb = Epi::PERM ? ((R & ~31) + perm32(R & 31)) : R;
        voffA[i] = (unsigned)(R * ld + C) * 2u; voffB[i] = (unsigned)(Rb * ld + C) * 2u; }
    const size_t kstep = (size_t)(BK * 2);
    const size_t hstep = (size_t)HALF * ld * 2;
    const unsigned ldsw = (unsigned)wid * 1024u;
    const int aoff = lds_byte(wr * 64 + fr, fq * 8), boff = lds_byte(wc * 32 + fr, fq * 8);
#define PG8_SA(b, h) (((b) * 2 + (h)) * HTB)
#define PG8_SB(b, h) ((4 + (b) * 2 + (h)) * HTB)
#define PG8_STAGE(bufoff, gbase, voff) do { _Pragma("unroll") for (int _i = 0; _i < 2; ++_i) \
        __builtin_amdgcn_global_load_lds((const unsigned*)((const char*)(gbase) + (voff)[_i]), (LAS unsigned*)(lds + (bufoff) + ldsw + _i * 8192), 16, 0, 0); } while (0)
#define PG8_LDA(dst, b, h) do { _Pragma("unroll") for (int m = 0; m < 4; ++m) _Pragma("unroll") for (int k = 0; k < 2; ++k) dst[m][k] = *(const LAS bf16x8*)(lds + PG8_SA(b, h) + aoff + m * 2048 + k * 1024); } while (0)
#define PG8_LDB(dst, b, h) do { _Pragma("unroll") for (int n = 0; n < 2; ++n) _Pragma("unroll") for (int k = 0; k < 2; ++k) dst[n][k] = *(const LAS bf16x8*)(lds + PG8_SB(b, h) + boff + n * 2048 + k * 1024); } while (0)
#define PG8_MMA(ai, bj, At, Bt) do { __builtin_amdgcn_s_setprio(1); _Pragma("unroll") for (int m = 0; m < 4; ++m) _Pragma("unroll") for (int n = 0; n < 2; ++n) _Pragma("unroll") for (int k = 0; k < 2; ++k) \
        acc[ai][bj][m][n] = __builtin_amdgcn_mfma_f32_16x16x32_bf16(Bt[n][k], At[m][k], acc[ai][bj][m][n], 0, 0, 0); __builtin_amdgcn_s_setprio(0); } while (0)
#define PG8_WAIT_V(n) asm volatile("s_waitcnt vmcnt(" #n ")" ::: "memory")
#define PG8_WAIT_L(n) asm volatile("s_waitcnt lgkmcnt(" #n ")" ::: "memory")
#define PG8_BAR __builtin_amdgcn_s_barrier()
#define PG8_SCHED __builtin_amdgcn_sched_barrier(0)
    Unit cur, nxt; int ui = 0;
    if (!S.next(0, cur)) return;
    f32x4 acc[2][2][4][2];
    E.init(acc, cur, wr, wc, fr, fq);
    bf16x8 At[4][2], B0[2][2], B1[2][2];
    const char* cA = S.a_base(cur); const char* cB = S.b_base(cur);
    const char* cA2 = cA; const char* cB2 = cB;
    if constexpr (SPLITK) { cA2 = S.a_base2(cur); cB2 = S.b_base2(cur); }
#define PG8_KTA(j) ((SPLITK && (j) >= nth) ? cA2 + (size_t)((j) - nth) * kstep : cA + (size_t)(j) * kstep)
#define PG8_KTB(j) ((SPLITK && (j) >= nth) ? cB2 + (size_t)((j) - nth) * kstep : cB + (size_t)(j) * kstep)
    PG8_STAGE(PG8_SB(0, 0), cB, voffB); PG8_STAGE(PG8_SB(0, 1), cB + hstep, voffB); PG8_STAGE(PG8_SA(0, 0), cA, voffA); PG8_STAGE(PG8_SA(0, 1), cA + hstep, voffA);
    if (wr == 1) PG8_BAR;
    PG8_WAIT_V(2); PG8_BAR;
    PG8_STAGE(PG8_SB(1, 0), cB + kstep, voffB); PG8_STAGE(PG8_SA(1, 0), cA + kstep, voffA); PG8_STAGE(PG8_SB(1, 1), cB + hstep + kstep, voffB);
    PG8_WAIT_V(6); PG8_BAR;
    for (;;) {
        const bool has_next = S.next(ui + 1, nxt);
        const char* nA = has_next ? S.a_base(nxt) : cA; const char* nB = has_next ? S.b_base(nxt) : cB;
        for (int t = 0; t < nt; t += 2) {
            const bool last = (t == nt - 2);
            const char* a1 = PG8_KTA(t + 1);
            const char* a2 = last ? nA : PG8_KTA(t + 2); const char* b2 = last ? nB : PG8_KTB(t + 2);
            const char* a3 = last ? nA + kstep : PG8_KTA(t + 3); const char* b3 = last ? nB + kstep : PG8_KTB(t + 3);
            if constexpr (SPLITK) { if (t == nth) E.mid(acc, cur, wr, wc, fr, fq); }
            PG8_LDB(B0, 0, 0); PG8_LDB(B1, 0, 1); PG8_SCHED; PG8_LDA(At, 0, 0); PG8_STAGE(PG8_SA(1, 1), a1 + hstep, voffA);
            PG8_WAIT_V(8); PG8_WAIT_L(0); PG8_BAR; PG8_MMA(0, 0, At, B0); PG8_MMA(0, 1, At, B1); PG8_BAR; PG8_SCHED;
            PG8_LDA(At, 0, 1); PG8_STAGE(PG8_SB(0, 0), b2, voffB); PG8_STAGE(PG8_SB(0, 1), b2 + hstep, voffB); PG8_STAGE(PG8_SA(0, 0), a2, voffA);
            PG8_WAIT_V(8); PG8_WAIT_L(0); PG8_BAR; PG8_MMA(1, 0, At, B0); PG8_MMA(1, 1, At, B1); PG8_BAR; PG8_SCHED;
            PG8_LDB(B0, 1, 0); PG8_LDB(B1, 1, 1); PG8_SCHED; PG8_LDA(At, 1, 0); PG8_STAGE(PG8_SA(0, 1), a2 + hstep, voffA);
            PG8_WAIT_V(8); PG8_WAIT_L(0); PG8_BAR; PG8_MMA(0, 0, At, B0); PG8_MMA(0, 1, At, B1); PG8_BAR; PG8_SCHED;
            PG8_LDA(At, 1, 1); PG8_STAGE(PG8_SB(1, 0), b3, voffB); PG8_STAGE(PG8_SB(1, 1), b3 + hstep, voffB); PG8_STAGE(PG8_SA(1, 0), a3, voffA);
            PG8_WAIT_V(8); PG8_WAIT_L(0); PG8_BAR; PG8_MMA(1, 0, At, B0); PG8_MMA(1, 1, At, B1); PG8_BAR; PG8_SCHED;
        }
        if (wr == 0) PG8_BAR;
        E(acc, cur, wr, wc, fr, fq);
        if (!has_next) break;
        E.init(acc, nxt, wr, wc, fr, fq);
        cur = nxt; cA = nA; cB = nB; ++ui;
        if constexpr (SPLITK) { cA2 = S.a_base2(cur); cB2 = S.b_base2(cur); }
        if (wr == 1) PG8_BAR;
    }
    PG8_WAIT_V(0);
    PG8_BAR;
#undef PG8_KTA
#undef PG8_KTB
#undef PG8_SA
#undef PG8_SB
#undef PG8_STAGE
#undef PG8_LDA
#undef PG8_LDB
#undef PG8_MMA
#undef PG8_WAIT_V
#undef PG8_WAIT_L
#undef PG8_BAR
#undef PG8_SCHED
}
}
using pg8::Unit;

struct SchedIn {
    const char* A; const char* B; int G, c;
    __device__ __forceinline__ bool next(int i, Unit& u) const {
        const int L = i * G + c; constexpr int NREG = 32 * 42;
        if (L < NREG) { pg8::tile_of(L, 32, 42, u); return true; }
        if (L < NREG + 10) { u.pm = 32; u.pn = 8 + (L - NREG); u.sub = 0; return true; }
        return false;
    }
    __device__ __forceinline__ const char* a_base(const Unit& u) const { return A + (size_t)u.pm * (256u * DM * 2u); }
    __device__ __forceinline__ const char* b_base(const Unit& u) const { return B + (size_t)u.pn * (256u * DM * 2u); }
};
struct SchedMix {
    const char* A0; const char* A1; const char* B0; const char* B1; int G, c;
    __device__ __forceinline__ bool next(int i, Unit& u) const {
        const int L = i * G + c; if (L >= 32 * 8) return false;
        pg8::tile_of(L, 32, 8, u); return true;
    }
    __device__ __forceinline__ const char* a_base(const Unit& u) const { return A0 + (size_t)u.pm * (256u * DM * 2u); }
    __device__ __forceinline__ const char* b_base(const Unit& u) const { return B0 + (size_t)u.pn * (256u * DM * 2u); }
    __device__ __forceinline__ const char* a_base2(const Unit& u) const { return A1 + (size_t)u.pm * (256u * DM * 2u); }
    __device__ __forceinline__ const char* b_base2(const Unit& u) const { return B1 + (size_t)u.pn * (256u * DM * 2u); }
};
struct SchedPlain {
    const char* A; const char* B; int nM, nN, K, G, c;
    __device__ __forceinline__ bool next(int i, Unit& u) const {
        const int L = i * G + c; if (L >= nM * nN) return false;
        pg8::tile_of(L, nM, nN, u); return true;
    }
    __device__ __forceinline__ const char* a_base(const Unit& u) const { return A + (size_t)u.pm * 256u * (size_t)K * 2u; }
    __device__ __forceinline__ const char* b_base(const Unit& u) const { return B + (size_t)u.pn * 256u * (size_t)K * 2u; }
};

__device__ __forceinline__ void acc_zero(f32x4 (&acc)[2][2][4][2]) {
#pragma unroll
    for (int a = 0; a < 2; ++a)
#pragma unroll
        for (int b = 0; b < 2; ++b)
#pragma unroll
            for (int m = 0; m < 4; ++m)
#pragma unroll
                for (int n = 0; n < 2; ++n) acc[a][b][m][n] = (f32x4){0.f, 0.f, 0.f, 0.f};
}
#define EPI_ZERO_INIT __device__ __forceinline__ void init(f32x4 (&acc)[2][2][4][2], const Unit&, int, int, int, int) const { acc_zero(acc); }
__device__ __forceinline__ void acc_load_f32(f32x4 (&acc)[2][2][4][2], const float* src, const Unit& u, int wr, int wc, int fr, int fq) {
    const int row0 = u.pm * 256 + wr * 64 + fr, col0 = u.pn * 256 + wc * 32 + 4 * fq;
#pragma unroll
    for (int ai = 0; ai < 2; ++ai)
#pragma unroll
        for (int m = 0; m < 4; ++m) { const size_t off = (size_t)(row0 + ai * 128 + m * 16) * DM + col0;
#pragma unroll
            for (int bj = 0; bj < 2; ++bj)
#pragma unroll
                for (int n = 0; n < 2; ++n) acc[ai][bj][m][n] = __builtin_nontemporal_load((const f32x4*)(src + off + bj * 128 + n * 16)); }
}
struct EpiIn {
    static constexpr bool PERM = true;
    bf16_t *Q, *Kb, *Vb, *LX, *LG, *GA, *GL;
    EPI_ZERO_INIT
    __device__ __forceinline__ void operator()(const f32x4 (&acc)[2][2][4][2], const Unit& u, int wr, int wc, int fr, int fq) const {
        const int pn = u.pn; int mode = 0, ldc = DM, colt; bf16_t* base;
        if (pn < 8) { base = Q; colt = pn * 256; }
        else if (pn == 8) { base = Kb; ldc = KVW; colt = 0; }
        else if (pn == 9) { base = Vb; ldc = KVW; colt = 0; }
        else if (pn < 18) { base = LX; colt = (pn - 10) * 256; }
        else if (pn < 26) { base = LG; colt = (pn - 18) * 256; mode = 1; }
        else {
            const int row0g = u.pm * 256 + wr * 64 + fr, ch0 = (pn - 26) * 128 + wc * 32 + 8 * fq;
#pragma unroll
            for (int ai = 0; ai < 2; ++ai)
#pragma unroll
                for (int m = 0; m < 4; ++m) { const size_t off = (size_t)(row0g + ai * 128 + m * 16) * DM + ch0;
                    float sr[8], sl[8];
#pragma unroll
                    for (int e = 0; e < 4; ++e) { const float a0 = fast_sigmoid(acc[ai][0][m][0][e]), a1 = fast_sigmoid(acc[ai][0][m][1][e]); sl[e] = fast_sigmoid(acc[ai][1][m][0][e]); sl[4 + e] = fast_sigmoid(acc[ai][1][m][1][e]);
                        sr[e] = a0 * __builtin_amdgcn_rcpf(fmaxf(sl[e], 1e-30f)); sr[4 + e] = a1 * __builtin_amdgcn_rcpf(fmaxf(sl[4 + e], 1e-30f)); }
                    u32x4 wr4, wl4;
                    wr4.x = cvt_pk_bf16(sr[0], sr[1]); wr4.y = cvt_pk_bf16(sr[2], sr[3]); wr4.z = cvt_pk_bf16(sr[4], sr[5]); wr4.w = cvt_pk_bf16(sr[6], sr[7]);
                    wl4.x = cvt_pk_bf16(sl[0], sl[1]); wl4.y = cvt_pk_bf16(sl[2], sl[3]); wl4.z = cvt_pk_bf16(sl[4], sl[5]); wl4.w = cvt_pk_bf16(sl[6], sl[7]);
                    __builtin_nontemporal_store(wr4, (u32x4*)(GA + off)); __builtin_nontemporal_store(wl4, (u32x4*)(GL + off)); }
            return;
        }
        const int row0 = u.pm * 256 + wr * 64 + fr, col0 = colt + wc * 32 + 8 * fq;
        const bool islx = (pn >= 10 && pn < 18);
#pragma unroll
        for (int ai = 0; ai < 2; ++ai)
#pragma unroll
            for (int m = 0; m < 4; ++m) { const int row = row0 + ai * 128 + m * 16; int orow = row;
                if (islx) orow = (row < MR) ? row + 16 * ((row >> 11) + 1) : row - MR;
                bf16_t* rowp = base + (size_t)orow * ldc + col0;
                const bool metarow = islx && row >= MR; if (metarow && row >= MR + NMETA) continue;
#pragma unroll
                for (int bj = 0; bj < 2; ++bj) { f32x4 v0 = acc[ai][bj][m][0], v1 = acc[ai][bj][m][1];
                    if (mode == 1) {
#pragma unroll
                        for (int e = 0; e < 4; ++e) { v0[e] = gelu_tanh(v0[e]); v1[e] = gelu_tanh(v1[e]); } }
                    else if (mode == 2) {
#pragma unroll
                        for (int e = 0; e < 4; ++e) { v0[e] = fast_sigmoid(v0[e]); v1[e] = fast_sigmoid(v1[e]); } }
                    u32x4 w; w.x = cvt_pk_bf16(v0[0], v0[1]); w.y = cvt_pk_bf16(v0[2], v0[3]); w.z = cvt_pk_bf16(v1[0], v1[1]); w.w = cvt_pk_bf16(v1[2], v1[3]);
                    *(u32x4*)(rowp + bj * 128) = w;
                    if (metarow) { *(u32x4*)(rowp + (size_t)2064 * DM + bj * 128) = w; *(u32x4*)(rowp + (size_t)(2 * 2064) * DM + bj * 128) = w; *(u32x4*)(rowp + (size_t)(3 * 2064) * DM + bj * 128) = w; } } }
    }
};
struct EpiMix {
    static constexpr bool PERM = true;
    const bf16_t *GA, *GL; bf16_t* MIX;
    EPI_ZERO_INIT
    __device__ __forceinline__ void mid(f32x4 (&acc)[2][2][4][2], const Unit& u, int wr, int wc, int fr, int fq) const {
        const int row0 = u.pm * 256 + wr * 64 + fr, col0 = u.pn * 256 + wc * 32 + 8 * fq;
#pragma unroll
        for (int ai = 0; ai < 2; ++ai)
#pragma unroll
            for (int m = 0; m < 4; ++m) { const size_t off = (size_t)(row0 + ai * 128 + m * 16) * DM + col0;
#pragma unroll
                for (int bj = 0; bj < 2; ++bj) { const u32x4 aw = __builtin_nontemporal_load((const u32x4*)(GA + off + bj * 128));
                    const float ra[8] = {bf_lo(aw.x), bf_hi(aw.x), bf_lo(aw.y), bf_hi(aw.y), bf_lo(aw.z), bf_hi(aw.z), bf_lo(aw.w), bf_hi(aw.w)};
#pragma unroll
                    for (int e = 0; e < 4; ++e) { acc[ai][bj][m][0][e] *= ra[e]; acc[ai][bj][m][1][e] *= ra[4 + e]; } } }
    }
    __device__ __forceinline__ void operator()(const f32x4 (&acc)[2][2][4][2], const Unit& u, int wr, int wc, int fr, int fq) const {
        const int row0 = u.pm * 256 + wr * 64 + fr, col0 = u.pn * 256 + wc * 32 + 8 * fq;
#pragma unroll
        for (int ai = 0; ai < 2; ++ai)
#pragma unroll
            for (int m = 0; m < 4; ++m) { const size_t off = (size_t)(row0 + ai * 128 + m * 16) * DM + col0;
#pragma unroll
                for (int bj = 0; bj < 2; ++bj) { const f32x4 a0 = acc[ai][bj][m][0], a1 = acc[ai][bj][m][1];
                    const u32x4 gw = __builtin_nontemporal_load((const u32x4*)(GL + off + bj * 128));
                    u32x4 w; w.x = cvt_pk_bf16(a0[0] * bf_lo(gw.x), a0[1] * bf_hi(gw.x)); w.y = cvt_pk_bf16(a0[2] * bf_lo(gw.y), a0[3] * bf_hi(gw.y));
                    w.z = cvt_pk_bf16(a1[0] * bf_lo(gw.z), a1[1] * bf_hi(gw.z)); w.w = cvt_pk_bf16(a1[2] * bf_lo(gw.w), a1[3] * bf_hi(gw.w));
                    *(u32x4*)(MIX + off + bj * 128) = w; } }
    }
};
struct EpiRes {
    static constexpr bool PERM = false;
    const float* x; const float* g2; float* out; bf16_t* HG; float* rowss; int noatom;
    __device__ __forceinline__ void init(f32x4 (&acc)[2][2][4][2], const Unit& u, int wr, int wc, int fr, int fq) const { acc_load_f32(acc, x, u, wr, wc, fr, fq); }
    __device__ __forceinline__ void operator()(const f32x4 (&acc)[2][2][4][2], const Unit& u, int wr, int wc, int fr, int fq) const {
        const int row0 = u.pm * 256 + wr * 64 + fr, col0 = u.pn * 256 + wc * 32 + 4 * fq;
        f32x4 gv[2][2];
#pragma unroll
        for (int bj = 0; bj < 2; ++bj)
#pragma unroll
            for (int n = 0; n < 2; ++n) gv[bj][n] = *(const f32x4*)(g2 + col0 + bj * 128 + n * 16);
#pragma unroll
        for (int ai = 0; ai < 2; ++ai)
#pragma unroll
            for (int m = 0; m < 4; ++m) { const int row = row0 + ai * 128 + m * 16; const size_t off = (size_t)row * DM + col0; float ss = 0.f;
#pragma unroll
                for (int bj = 0; bj < 2; ++bj)
#pragma unroll
                    for (int n = 0; n < 2; ++n) { const f32x4 h = acc[ai][bj][m][n];
                        __builtin_nontemporal_store(h, (f32x4*)(out + off + bj * 128 + n * 16));
                        ss += (h[0] * h[0] + h[1] * h[1]) + (h[2] * h[2] + h[3] * h[3]);
                        const f32x4 hg = h * gv[bj][n]; u32x2 w; w.x = cvt_pk_bf16(hg[0], hg[1]); w.y = cvt_pk_bf16(hg[2], hg[3]);
                        *(u32x2*)(HG + off + bj * 128 + n * 16) = w; }
                ss += __shfl_xor(ss, 16); ss += __shfl_xor(ss, 32);
                if (fq == 0 && !noatom) atomicAdd(rowss + row, ss); }
    }
};
struct EpiUp {
    static constexpr bool PERM = true;
    const float* rowss; bf16_t* U;
    EPI_ZERO_INIT
    __device__ __forceinline__ void operator()(const f32x4 (&acc)[2][2][4][2], const Unit& u, int wr, int wc, int fr, int fq) const {
        const int row0 = u.pm * 256 + wr * 64 + fr, col0 = u.pn * 256 + wc * 32 + 8 * fq;
#pragma unroll
        for (int ai = 0; ai < 2; ++ai)
#pragma unroll
            for (int m = 0; m < 4; ++m) { const int row = row0 + ai * 128 + m * 16; const float rs = __builtin_amdgcn_rsqf(rowss[row] * (1.0f / DM) + EPS);
                bf16_t* rowp = U + (size_t)row * FF + col0;
#pragma unroll
                for (int bj = 0; bj < 2; ++bj) { f32x4 v0 = acc[ai][bj][m][0] * rs, v1 = acc[ai][bj][m][1] * rs;
#pragma unroll
                    for (int e = 0; e < 4; ++e) { const float a = fmaxf(v0[e], 0.f), b = fmaxf(v1[e], 0.f); v0[e] = a * a; v1[e] = b * b; }
                    u32x4 w; w.x = cvt_pk_bf16(v0[0], v0[1]); w.y = cvt_pk_bf16(v0[2], v0[3]); w.z = cvt_pk_bf16(v1[0], v1[1]); w.w = cvt_pk_bf16(v1[2], v1[3]);
                    *(u32x4*)(rowp + bj * 128) = w; } }
    }
};
struct EpiDown {
    static constexpr bool PERM = false;
    float* out; int nostore;
    __device__ __forceinline__ void init(f32x4 (&acc)[2][2][4][2], const Unit& u, int wr, int wc, int fr, int fq) const { acc_load_f32(acc, out, u, wr, wc, fr, fq); }
    __device__ __forceinline__ void operator()(const f32x4 (&acc)[2][2][4][2], const Unit& u, int wr, int wc, int fr, int fq) const {
        const int row0 = u.pm * 256 + wr * 64 + fr, col0 = u.pn * 256 + wc * 32 + 4 * fq;
#pragma unroll
        for (int ai = 0; ai < 2; ++ai)
#pragma unroll
            for (int m = 0; m < 4; ++m) { const size_t off = (size_t)(row0 + ai * 128 + m * 16) * DM + col0;
#pragma unroll
                for (int bj = 0; bj < 2; ++bj)
#pragma unroll
                    for (int n = 0; n < 2; ++n) { float* p = out + off + bj * 128 + n * 16; if (!nostore) __builtin_nontemporal_store(acc[ai][bj][m][n], (f32x4*)p); } }
    }
};

struct Args {
    const float *x, *meta, *norm1_g, *w_in, *q_norm_g, *k_norm_g, *sinks, *w_o_attn, *conv_w, *conv_b, *lru_wa, *lru_ba, *lru_wi, *lru_bi, *lru_lambda, *w_o_lru, *w_out, *norm2_g, *w_up, *w_down;
    float* out; unsigned char* ws; int ph_lo, ph_hi, flags, pad;
};

__device__ __forceinline__ float wave_sum(float v) {
#pragma unroll
    for (int o = 1; o < 64; o <<= 1) v += __shfl_xor(v, o);
    return v;
}
__device__ __forceinline__ void transpose_load(f32x4 (&v)[16], const float* __restrict__ W, int N, int item, int lane) {
    const int nblk = N >> 6, kb = item / nblk, nb = item - kb * nblk, k0 = kb * 64, n0 = nb * 64;
    const int lr = lane >> 4, lc = (lane & 15) * 4;
    const unsigned off0 = (unsigned)((k0 + lr) * N + n0 + lc), rstep = (unsigned)(4 * N);
#pragma unroll
    for (int i = 0; i < 16; ++i) v[i] = __builtin_nontemporal_load((const f32x4*)(W + (off0 + (unsigned)i * rstep)));
}
template <bool NT = false> __device__ __forceinline__ void transpose_store(const f32x4 (&v)[16], int K, int N, bf16_t* __restrict__ WT, int row_off, LAS float* scr, int item, int lane) {
    const int nblk = N >> 6, kb = item / nblk, nb = item - kb * nblk, k0 = kb * 64, n0 = nb * 64;
    const int lr = lane >> 4, lc = (lane & 15) * 4;
#pragma unroll
    for (int i = 0; i < 16; ++i) { LAS float* s = scr + (4 * i + lr) * 65 + lc; s[0] = v[i][0]; s[1] = v[i][1]; s[2] = v[i][2]; s[3] = v[i][3]; }
    LDS_WAIT(); asm volatile("" ::: "memory");
    const int c = lane & 7, ns = lane >> 3;
    bf16_t* wp = WT + (size_t)(row_off + n0 + ns) * K + k0 + 8 * c; const size_t wstep = (size_t)8 * K;
#pragma unroll
    for (int j = 0; j < 8; ++j) { const LAS float* s = scr + (8 * c) * 65 + ns + 8 * j;
        u32x4 o; o.x = cvt_pk_bf16(s[0 * 65], s[1 * 65]); o.y = cvt_pk_bf16(s[2 * 65], s[3 * 65]); o.z = cvt_pk_bf16(s[4 * 65], s[5 * 65]); o.w = cvt_pk_bf16(s[6 * 65], s[7 * 65]);
        if (NT) __builtin_nontemporal_store(o, (u32x4*)wp); else *(u32x4*)wp = o;
        wp += wstep; asm volatile("" : "+v"(wp)); }
    LDS_WAIT(); asm volatile("" ::: "memory");
}
__device__ __forceinline__ void transpose_item(const float* __restrict__ W, int K, int N, bf16_t* __restrict__ WT, int row_off, LAS float* scr, int item, int lane) {
    f32x4 v[16]; transpose_load(v, W, N, item, lane); transpose_store(v, K, N, WT, row_off, scr, item, lane);
}
__device__ __forceinline__ void rms_row_to_bf16(const float* xrow, const float* g, bf16_t* orow, int lane) {
    const f32x4* xr = (const f32x4*)xrow + lane; const f32x4* gr = (const f32x4*)g + lane;
    f32x4 v[8], gv[8]; float s = 0.f;
#pragma unroll
    for (int j = 0; j < 8; ++j) { v[j] = xr[64 * j]; gv[j] = gr[64 * j]; }
#pragma unroll
    for (int j = 0; j < 8; ++j) s += (v[j][0] * v[j][0] + v[j][1] * v[j][1]) + (v[j][2] * v[j][2] + v[j][3] * v[j][3]);
    const float rs = 1.0f / sqrtf(wave_sum(s) * (1.0f / DM) + EPS);
    u32x2* o8 = (u32x2*)orow + lane;
#pragma unroll
    for (int j = 0; j < 8; ++j) { const f32x4 gg = gv[j]; u32x2 w; w.x = cvt_pk_bf16(v[j][0] * rs * gg[0], v[j][1] * rs * gg[1]); w.y = cvt_pk_bf16(v[j][2] * rs * gg[2], v[j][3] * rs * gg[3]); o8[64 * j] = w; }
}


#define XB_TMO      128
#define XB_XCNT(j)  (256  + 64 * (j))
#define XB_XSUB(j)  (1280 + 64 * (j))
#define XB_XGEN(j)  (2304 + 64 * (j))
#define XB_TOP      3328
#define XB_TOPGEN   3392
#define XCD_BAR_WORDS 3456
#define XB_SPIN_CAP (1u << 18)
__device__ __forceinline__ unsigned xb_ld(unsigned* p)              { return __hip_atomic_load(p, __ATOMIC_RELAXED, __HIP_MEMORY_SCOPE_AGENT); }
__device__ __forceinline__ unsigned xb_add(unsigned* p, unsigned v) { return __hip_atomic_fetch_add(p, v, __ATOMIC_RELAXED, __HIP_MEMORY_SCOPE_AGENT); }
__device__ __forceinline__ unsigned xb_xcc_id() { return (unsigned)__builtin_amdgcn_s_getreg((3 << 11) | 20) & 0xFu; }
#define XB_SPIN(cond, bar) do { unsigned _sp = 0; while (cond) { __builtin_amdgcn_s_sleep(1); \
    if ((++_sp & 255u) == 0u) { if (xb_ld(&(bar)[XB_TMO])) break; if (_sp > XB_SPIN_CAP) { atomicAdd(&(bar)[XB_TMO], 1u); break; } } } } while (0)
struct XcdBarrier { unsigned* bar; unsigned x; volatile LAS unsigned* st; };
__device__ __forceinline__ XcdBarrier xcd_barrier_post(unsigned* bar, volatile LAS unsigned* st) {
    XcdBarrier b; b.bar = bar; b.x = xb_xcc_id(); b.st = st;
    if (threadIdx.x == 0) (void)xb_add(&bar[XB_XCNT(b.x)], 1u);
    return b;
}
__device__ __forceinline__ void xcd_barrier_complete(unsigned* bar, unsigned x, unsigned& nloc, unsigned& nx) {
    const unsigned G = gridDim.x * gridDim.y * gridDim.z;
    unsigned sum, cnt, mine, sp = 0u;
    for (;;) {
        sum = 0u; cnt = 0u; mine = 0u;
#pragma unroll
        for (unsigned j = 0; j < 16; ++j) { const unsigned c = xb_ld(&bar[XB_XCNT(j)]); sum += c; cnt += (c > 0u) ? 1u : 0u; mine = (j == x) ? c : mine; }
        if (sum == G) break;
        __builtin_amdgcn_s_sleep(1);
        if ((++sp & 255u) == 0u) { if (xb_ld(&bar[XB_TMO])) break; if (sp > XB_SPIN_CAP) { atomicAdd(&bar[XB_TMO], 1u); break; } }
    }
    nloc = mine > 0u ? mine : 1u; nx = cnt > 0u ? cnt : 1u;
}
__device__ __forceinline__ void xcd_barrier(const XcdBarrier& b) {
    asm volatile("s_waitcnt vmcnt(0)" ::: "memory");
    __syncthreads();
    if (threadIdx.x == 0) {
        unsigned* bar = b.bar;
        __builtin_amdgcn_s_waitcnt(0);
        unsigned nloc = b.st[0], nx = b.st[1];
        if (nloc == 0u) { xcd_barrier_complete(bar, b.x, nloc, nx); b.st[0] = nloc; b.st[1] = nx; }
        const unsigned old = xb_add(&bar[XB_XSUB(b.x)], 1u);
        const unsigned gen = old / nloc;
        if (old + 1u == (gen + 1u) * nloc) {
            __builtin_amdgcn_fence(__ATOMIC_RELEASE, "agent");
            asm volatile("s_waitcnt vmcnt(0)" ::: "memory");
            const unsigned og = xb_add(&bar[XB_TOP], 1u);
            const unsigned tg = og / nx;
            if (og + 1u == (tg + 1u) * nx) xb_add(&bar[XB_TOPGEN], 1u);
            else XB_SPIN(xb_ld(&bar[XB_TOPGEN]) == tg, bar);
            __builtin_amdgcn_fence(__ATOMIC_ACQUIRE, "agent");
            xb_add(&bar[XB_XGEN(b.x)], 1u);
            asm volatile("s_waitcnt vmcnt(0)" ::: "memory");
        } else {
            XB_SPIN(xb_ld(&bar[XB_XGEN(b.x)]) == gen, bar);
            __builtin_amdgcn_fence(__ATOMIC_ACQUIRE, "agent");
            asm volatile("s_waitcnt vmcnt(0)" ::: "memory");
        }
    }
    __syncthreads();
}

__global__ void __launch_bounds__(NTHREADS, 2) fwd_kernel(Args a) {
    extern __shared__ __attribute__((aligned(16))) unsigned char lds_raw[];
    LAS unsigned char* lds = (LAS unsigned char*)lds_raw;
    const int tid = threadIdx.x, lane = tid & 63, wave = __builtin_amdgcn_readfirstlane(tid >> 6);
    const int G = gridDim.x, bid = blockIdx.x;
    unsigned char* ws = a.ws;
    float* rowss = (float*)(ws + WS_CTL);
    bf16_t* Wt_in = (bf16_t*)(ws + WS_WTIN); bf16_t* XN = (bf16_t*)(ws + WS_XN);
    bf16_t* Wt_up = (bf16_t*)(ws + WS_WTUP); bf16_t* Wt_dn = (bf16_t*)(ws + WS_WTDN);
    bf16_t* Wt_oa = (bf16_t*)(ws + WS_WOA); bf16_t* Wt_ol = (bf16_t*)(ws + WS_WOL); bf16_t* Wt_out = (bf16_t*)(ws + WS_WOUT);
    bf16_t* Wt_a = (bf16_t*)(ws + WS_WA); bf16_t* Wt_i = (bf16_t*)(ws + WS_WI);
    bf16_t* Qb = (bf16_t*)(ws + WS_Q); bf16_t* Kb = (bf16_t*)(ws + WS_K); bf16_t* Vb = (bf16_t*)(ws + WS_V);
    bf16_t* LX = (bf16_t*)(ws + WS_LX); bf16_t* LG = (bf16_t*)(ws + WS_LG); bf16_t* GA = (bf16_t*)(ws + WS_GA); bf16_t* GL = (bf16_t*)(ws + WS_GL);
    bf16_t* MIX = LX; bf16_t* HG = Qb; bf16_t* U = (bf16_t*)(ws + WS_U); bf16_t* Ob = (bf16_t*)(ws + WS_O); bf16_t* REC = (bf16_t*)(ws + WS_REC);
    const int lo = a.ph_lo, hi = a.ph_hi;
#define IN(k) (lo <= (k) && (k) < hi)
    volatile LAS unsigned* bst = (volatile LAS unsigned*)(lds + LDS_BYTES - 16);
    if (tid < 4) bst[tid] = 0u;
    __syncthreads();
    const XcdBarrier xbar = xcd_barrier_post((unsigned*)(ws + WS_BAR) + (a.flags >> 8) * XCD_BAR_WORDS, bst);
#define SEAM(k) do { if (IN(k) && IN((k) + 1)) { xcd_barrier(xbar); } } while (0)
    if (a.ph_lo < 0) cg::this_grid().sync();

    if (IN(0)) {
        LAS float* scr = (LAS float*)(lds + wave * 16640);
        const int gw = bid * NWAVES + wave, NGW = G * NWAVES;
        constexpr int I_IN = 32 * 168, I_LRU = 16 * 16, NITEMS = I_IN + I_LRU;
#define P0_DESC(IT, W_, K_, N_, WT_, RO_, LI_) do { int r_ = (IT) < NITEMS ? (IT) : NITEMS - 1;   \
            if (r_ < I_IN) { const int n0_ = (r_ % (INW / 64)) * 64; int ro_ = 0;     \
                if (n0_ >= 6656) { const int c_ = n0_ - 6656, isgl_ = c_ >> 11, cc_ = c_ & 2047; ro_ = 6656 + (cc_ >> 7) * 256 + isgl_ * 128 + (cc_ & 127) - n0_; } \
                W_ = a.w_in; K_ = DM; N_ = INW; WT_ = Wt_in; RO_ = ro_; LI_ = r_; } \
            else { const int q_ = r_ - I_IN, mat_ = q_ >> 4, which_ = mat_ >> 3, n_ = mat_ & 7; \
                W_ = (which_ ? a.lru_wi : a.lru_wa) + (size_t)n_ * 65536; K_ = 256; N_ = 256; WT_ = which_ ? Wt_i : Wt_a; RO_ = n_ * 256; LI_ = q_ & 15; } } while (0)
        {
            f32x4 va[16], vb[16], vc[16];
            const float* wA; bf16_t* tA; int kA, nA, rA, lA; const float* wB; bf16_t* tB; int kB, nB, rB, lB; const float* wC; bf16_t* tC; int kC, nC, rC, lC;
            P0_DESC(gw, wA, kA, nA, tA, rA, lA); transpose_load(va, wA, nA, lA, lane);
            P0_DESC(gw + NGW, wB, kB, nB, tB, rB, lB); transpose_load(vb, wB, nB, lB, lane);
#pragma unroll 1
            for (int it = gw; it < NITEMS; it += 3 * NGW) {
                P0_DESC(it + 2 * NGW, wC, kC, nC, tC, rC, lC); transpose_load(vc, wC, nC, lC, lane);
                transpose_store(va, kA, nA, tA, rA, scr, lA, lane);
                P0_DESC(it + 3 * NGW, wA, kA, nA, tA, rA, lA); transpose_load(va, wA, nA, lA, lane);
                transpose_store(vb, kB, nB, tB, rB, scr, lB, lane);
                P0_DESC(it + 4 * NGW, wB, kB, nB, tB, rB, lB); transpose_load(vb, wB, nB, lB, lane);
                transpose_store(vc, kC, nC, tC, rC, scr, lC, lane);
            }
        }
#undef P0_DESC
        {
            const f32x4* gr = (const f32x4*)a.norm1_g + lane; f32x4 gv[8];
#pragma unroll
            for (int j = 0; j < 8; ++j) gv[j] = gr[64 * j];
#define P0_ROWSRC(M) ((M) < MR ? a.x + (size_t)(M) * DM : a.meta + (size_t)(((M) < MR + NMETA ? (M) : MR + NMETA - 1) - MR) * DM)
            f32x4 vn[8];
            { const f32x4* xr = (const f32x4*)P0_ROWSRC(gw) + lane;
#pragma unroll
              for (int j = 0; j < 8; ++j) vn[j] = __builtin_nontemporal_load(xr + 64 * j); }
#pragma unroll 1
            for (int m = gw; m < MR + NMETA; m += NGW) {
                f32x4 v[8];
#pragma unroll
                for (int j = 0; j < 8; ++j) v[j] = vn[j];
                { const f32x4* xr = (const f32x4*)P0_ROWSRC(m + NGW) + lane;
#pragma unroll
                  for (int j = 0; j < 8; ++j) vn[j] = __builtin_nontemporal_load(xr + 64 * j); }
                float ssq = 0.f;
#pragma unroll
                for (int j = 0; j < 8; ++j) ssq += (v[j][0] * v[j][0] + v[j][1] * v[j][1]) + (v[j][2] * v[j][2] + v[j][3] * v[j][3]);
                const float rs = 1.0f / sqrtf(wave_sum(ssq) * (1.0f / DM) + EPS);
                u32x2* o8 = (u32x2*)(XN + (size_t)m * DM) + lane;
#pragma unroll
                for (int j = 0; j < 8; ++j) { u32x2 w; w.x = cvt_pk_bf16(v[j][0] * rs * gv[j][0], v[j][1] * rs * gv[j][1]); w.y = cvt_pk_bf16(v[j][2] * rs * gv[j][2], v[j][3] * rs * gv[j][3]); o8[64 * j] = w; }
            }
#undef P0_ROWSRC
            for (int m = MR + NMETA + gw; m < MPAD; m += NGW) { u32x4* o = (u32x4*)(XN + (size_t)m * DM) + lane;
#pragma unroll
                for (int j = 0; j < 4; ++j) o[64 * j] = (u32x4){0u, 0u, 0u, 0u}; }
        }
        for (int i = bid * NTHREADS + tid; i < MR; i += G * NTHREADS) rowss[i] = 0.f;
    }
    SEAM(0);

    if (IN(1)) {
        const int NT_CU = (G >= 128) ? (G * 30) / 256 : 0, NG = G - NT_CU;
        if (bid < NG) {
            SchedIn S{(const char*)XN, (const char*)Wt_in, NG, bid};
            EpiIn E{Qb, Kb, Vb, LX, LG, GA, GL};
            pg8::gemm_phase<EpiIn, SchedIn>(lds, DM, S, E);
        }
        if (bid >= NG || NT_CU == 0) {
            LAS float* scr = (LAS float*)(lds + wave * 16640);
            const int gw = (NT_CU ? bid - NG : bid) * NWAVES + wave, NGW = (NT_CU ? NT_CU : G) * NWAVES;
            constexpr int I_UP = 32 * 128, I_DN = 128 * 32, I_SQ1 = 32 * 32, NIT = I_UP + I_DN + 3 * I_SQ1;
#define P1_DESC(IT, W_, K_, N_, WT_, LI_) do { const int r_ = (IT) < NIT ? (IT) : NIT - 1;   \
                if (r_ < I_UP) { W_ = a.w_up; K_ = DM; N_ = FF; WT_ = Wt_up; LI_ = r_; } \
                else if (r_ < I_UP + I_DN) { W_ = a.w_down; K_ = FF; N_ = DM; WT_ = Wt_dn; LI_ = r_ - I_UP; } \
                else if (r_ < I_UP + I_DN + I_SQ1) { W_ = a.w_o_attn; K_ = DM; N_ = DM; WT_ = Wt_oa; LI_ = r_ - I_UP - I_DN; } \
                else if (r_ < I_UP + I_DN + 2 * I_SQ1) { W_ = a.w_o_lru; K_ = DM; N_ = DM; WT_ = Wt_ol; LI_ = r_ - I_UP - I_DN - I_SQ1; } \
                else { W_ = a.w_out; K_ = DM; N_ = DM; WT_ = Wt_out; LI_ = r_ - I_UP - I_DN - 2 * I_SQ1; } } while (0)
            f32x4 va[16], vb[16];
            const float* wA; bf16_t* tA; int kA, nA, lA; const float* wB; bf16_t* tB; int kB, nB, lB;
            P1_DESC(gw, wA, kA, nA, tA, lA); transpose_load(va, wA, nA, lA, lane);
#pragma unroll 1
            for (int it = gw; it < NIT; it += 2 * NGW) {
                P1_DESC(it + NGW, wB, kB, nB, tB, lB); transpose_load(vb, wB, nB, lB, lane);
                transpose_store<true>(va, kA, nA, tA, 0, scr, lA, lane);
                P1_DESC(it + 2 * NGW, wA, kA, nA, tA, lA); transpose_load(va, wA, nA, lA, lane);
                transpose_store<true>(vb, kB, nB, tB, 0, scr, lB, lane);
            }
#undef P1_DESC
        }
    }
    SEAM(1);

    {
        if (IN(3)) {
            constexpr int KS_STRIDE = 144  , VT_STRIDE = 552  , VT_OFF = 39424;
            const int fr = lane & 15, fq = lane >> 4;
            for (int unit = bid; unit < 256; unit += G) {
                const int b = unit >> 6, qb = (unit >> 2) & 15, g = unit & 3;
                {
                    const int ch = tid & 7;
                    float gk[8];
#pragma unroll
                    for (int e = 0; e < 8; ++e) gk[e] = a.k_norm_g[ch * 8 + e];
                    u32x4 kws[5], vws[5];
#pragma unroll
                    for (int it = 0; it < 5; ++it) {
                        const int key = (it * NTHREADS + tid) >> 3;
                        bool ld = key < 272; int row = 0;
                        if (key < 16) row = MR + key;
                        else { const int ik = key - 16; row = b * SEQ + qb * 128 - 128 + ik; if (qb == 0 && ik < 128) ld = false; }
                        kws[it] = (u32x4){0u, 0u, 0u, 0u}; vws[it] = (u32x4){0u, 0u, 0u, 0u};
                        if (ld) { kws[it] = *(const u32x4*)(Kb + (size_t)row * KVW + g * 64 + ch * 8); vws[it] = *(const u32x4*)(Vb + (size_t)row * KVW + g * 64 + ch * 8); }
                    }
#pragma unroll
                    for (int it = 0; it < 5; ++it) {
                        const int key = (it * NTHREADS + tid) >> 3;
                        const u32x4 kw = kws[it], vw = vws[it];
                        float kf[8] = {bf_lo(kw.x), bf_hi(kw.x), bf_lo(kw.y), bf_hi(kw.y), bf_lo(kw.z), bf_hi(kw.z), bf_lo(kw.w), bf_hi(kw.w)};
                        float ss = 0.f;
#pragma unroll
                        for (int e = 0; e < 8; ++e) ss += kf[e] * kf[e];
                        ss += __shfl_xor(ss, 1); ss += __shfl_xor(ss, 2); ss += __shfl_xor(ss, 4);
                        const float sc = 1.0f / sqrtf(ss * (1.0f / 64.0f) + EPS);
                        if (key < 272) {
                            u32x4 o; o.x = cvt_pk_bf16(kf[0] * sc * gk[0], kf[1] * sc * gk[1]); o.y = cvt_pk_bf16(kf[2] * sc * gk[2], kf[3] * sc * gk[3]);
                            o.z = cvt_pk_bf16(kf[4] * sc * gk[4], kf[5] * sc * gk[5]); o.w = cvt_pk_bf16(kf[6] * sc * gk[6], kf[7] * sc * gk[7]);
                            *(LAS u32x4*)(lds + key * KS_STRIDE + ch * 16) = o;
                            LAS bf16_t* vt = (LAS bf16_t*)(lds + VT_OFF + (ch * 8) * VT_STRIDE + key * 2);
                            vt[0 * (VT_STRIDE / 2)] = (bf16_t)(vw.x & 0xffffu); vt[1 * (VT_STRIDE / 2)] = (bf16_t)(vw.x >> 16);
                            vt[2 * (VT_STRIDE / 2)] = (bf16_t)(vw.y & 0xffffu); vt[3 * (VT_STRIDE / 2)] = (bf16_t)(vw.y >> 16);
                            vt[4 * (VT_STRIDE / 2)] = (bf16_t)(vw.z & 0xffffu); vt[5 * (VT_STRIDE / 2)] = (bf16_t)(vw.z >> 16);
                            vt[6 * (VT_STRIDE / 2)] = (bf16_t)(vw.w & 0xffffu); vt[7 * (VT_STRIDE / 2)] = (bf16_t)(vw.w >> 16);
                        }
                    }
                }
                __syncthreads();
                const int h = g * 8 + wave;
                const float sinkl = a.sinks[h] * LOG2E;
                float gq[16];
#pragma unroll
                for (int e = 0; e < 8; ++e) { gq[e] = a.q_norm_g[8 * fq + e]; gq[8 + e] = a.q_norm_g[32 + 8 * fq + e]; }
                u32x4 q0n, q1n;
                { const bf16_t* qp0 = Qb + (size_t)(b * SEQ + qb * 128 + fr) * DM + h * 64; q0n = *(const u32x4*)(qp0 + 8 * fq); q1n = *(const u32x4*)(qp0 + 32 + 8 * fq); }
#pragma unroll 1
                for (int mt = 0; mt < 8; ++mt) {
                    const size_t qrow = (size_t)(b * SEQ + qb * 128 + mt * 16 + fr);
                    const u32x4 q0 = q0n, q1 = q1n;
                    { const bf16_t* qpn = Qb + (qrow + (mt < 7 ? 16 : 0)) * DM + h * 64; q0n = *(const u32x4*)(qpn + 8 * fq); q1n = *(const u32x4*)(qpn + 32 + 8 * fq); }
                    float qf[16] = {bf_lo(q0.x), bf_hi(q0.x), bf_lo(q0.y), bf_hi(q0.y), bf_lo(q0.z), bf_hi(q0.z), bf_lo(q0.w), bf_hi(q0.w),
                                    bf_lo(q1.x), bf_hi(q1.x), bf_lo(q1.y), bf_hi(q1.y), bf_lo(q1.z), bf_hi(q1.z), bf_lo(q1.w), bf_hi(q1.w)};
                    float ss = 0.f;
#pragma unroll
                    for (int e = 0; e < 16; ++e) ss += qf[e] * qf[e];
                    ss += __shfl_xor(ss, 16); ss += __shfl_xor(ss, 32);
                    const float sc = (0.125f * LOG2E) / sqrtf(ss * (1.0f / 64.0f) + EPS);
                    u32x4 qa, qc;
                    qa.x = cvt_pk_bf16(qf[0] * sc * gq[0], qf[1] * sc * gq[1]); qa.y = cvt_pk_bf16(qf[2] * sc * gq[2], qf[3] * sc * gq[3]);
                    qa.z = cvt_pk_bf16(qf[4] * sc * gq[4], qf[5] * sc * gq[5]); qa.w = cvt_pk_bf16(qf[6] * sc * gq[6], qf[7] * sc * gq[7]);
                    qc.x = cvt_pk_bf16(qf[8] * sc * gq[8], qf[9] * sc * gq[9]); qc.y = cvt_pk_bf16(qf[10] * sc * gq[10], qf[11] * sc * gq[11]);
                    qc.z = cvt_pk_bf16(qf[12] * sc * gq[12], qf[13] * sc * gq[13]); qc.w = cvt_pk_bf16(qf[14] * sc * gq[14], qf[15] * sc * gq[15]);
                    const bf16x8 qfr0 = __builtin_bit_cast(bf16x8, qa), qfr1 = __builtin_bit_cast(bf16x8, qc);
                    f32x4 st[10];
#pragma unroll
                    for (int j = 0; j < 10; ++j) {
                        const int kbase = (j == 0) ? 0 : 16 + 16 * (mt + j - 1);
                        const LAS unsigned char* kp = lds + (kbase + fr) * KS_STRIDE + fq * 16;
                        const bf16x8 k0 = *(const LAS bf16x8*)(kp), k1 = *(const LAS bf16x8*)(kp + 64);
                        f32x4 s = (f32x4){0.f, 0.f, 0.f, 0.f};
                        s = __builtin_amdgcn_mfma_f32_16x16x32_bf16(k0, qfr0, s, 0, 0, 0);
                        s = __builtin_amdgcn_mfma_f32_16x16x32_bf16(k1, qfr1, s, 0, 0, 0);
                        st[j] = s;
                    }
#pragma unroll
                    for (int r = 0; r < 4; ++r) { const int d1 = 4 * fq + r - fr; st[1][r] = (d1 >= 1) ? st[1][r] : -1e30f; st[9][r] = (d1 <= 0) ? st[9][r] : -1e30f; }
                    if (qb == 0) {
#pragma unroll
                        for (int j = 1; j < 10; ++j)
#pragma unroll
                            for (int r = 0; r < 4; ++r) st[j][r] = ((16 * (mt + j - 1) + 4 * fq + r) < 128) ? -1e30f : st[j][r];
                    }
                    float mx = sinkl;
#pragma unroll
                    for (int j = 0; j < 10; ++j) mx = fmaxf(fmaxf(mx, fmaxf(st[j][0], st[j][1])), fmaxf(st[j][2], st[j][3]));
                    mx = fmaxf(mx, __shfl_xor(mx, 16)); mx = fmaxf(mx, __shfl_xor(mx, 32));
                    float den = 0.f;
#pragma unroll
                    for (int j = 0; j < 10; ++j)
#pragma unroll
                        for (int r = 0; r < 4; ++r) { const float p = __builtin_amdgcn_exp2f(st[j][r] - mx); st[j][r] = p; den += p; }
                    den += __shfl_xor(den, 16); den += __shfl_xor(den, 32);
                    den += __builtin_amdgcn_exp2f(sinkl - mx);
                    const float rden = 1.0f / den;
                    f32x4 o[4];
#pragma unroll
                    for (int dt = 0; dt < 4; ++dt) o[dt] = (f32x4){0.f, 0.f, 0.f, 0.f};
#pragma unroll
                    for (int kp = 0; kp < 5; ++kp) {
                        u32x4 pw; pw.x = cvt_pk_bf16(st[2 * kp][0], st[2 * kp][1]); pw.y = cvt_pk_bf16(st[2 * kp][2], st[2 * kp][3]);
                        pw.z = cvt_pk_bf16(st[2 * kp + 1][0], st[2 * kp + 1][1]); pw.w = cvt_pk_bf16(st[2 * kp + 1][2], st[2 * kp + 1][3]);
                        const bf16x8 pfr = __builtin_bit_cast(bf16x8, pw);
                        const int kb0 = (kp == 0) ? 0 : 16 + 16 * (mt + 2 * kp - 1), kb1 = 16 + 16 * (mt + 2 * kp);
#pragma unroll
                        for (int dt = 0; dt < 4; ++dt) {
                            const LAS unsigned char* vp = lds + VT_OFF + (16 * dt + fr) * VT_STRIDE + 8 * fq;
                            const u32x2 va = *(const LAS u32x2*)(vp + 2 * kb0), vb = *(const LAS u32x2*)(vp + 2 * kb1);
                            const u32x4 vv = (u32x4){va.x, va.y, vb.x, vb.y};
                            o[dt] = __builtin_amdgcn_mfma_f32_16x16x32_bf16(__builtin_bit_cast(bf16x8, vv), pfr, o[dt], 0, 0, 0);
                        }
                    }
#pragma unroll
                    for (int dt = 0; dt < 4; ++dt) { u32x2 w; w.x = cvt_pk_bf16(o[dt][0] * rden, o[dt][1] * rden); w.y = cvt_pk_bf16(o[dt][2] * rden, o[dt][3] * rden);
                        *(u32x2*)(Ob + qrow * DM + h * 64 + 16 * dt + 4 * fq) = w; }
                }
                __syncthreads();
            }
        }
        if (IN(4)) {
            constexpr int AT_STRIDE = 528  , WL_OFF = 67584, AB_OFF = 101376, BB_OFF = 117888, SEG_OFF = 134400, CARRY_OFF = 138496, GC_OFF = 138752, CW_OFF = 139136, ABS = 129  ;
            static_assert(CW_OFF + 5120 <= LDS_BYTES, "LRU LDS map");
            const int fr = lane & 15, fq = lane >> 4;
            for (int itb = bid; itb < 256; itb += G) {
                const int item = (G == 256) ? (itb & 7) * 32 + (itb >> 3) : itb;
                const int b = item >> 6, n = (item >> 3) & 7, d0 = (item & 7) * 32, cb = n * 256 + d0;
                const int cg8 = tid & 31, seg = tid >> 5; const int cch = n * 256 + cg8 * 8;
                {
                    u32x4 wtmp[4]; float ctmp[3], gtmp[3];
#pragma unroll
                    for (int k = 0; k < 4; ++k) { const int i = tid + k * NTHREADS, gate = i >> 10, dd = (i >> 5) & 31, kc = i & 31;
                        wtmp[k] = *(const u32x4*)((gate ? Wt_i : Wt_a) + (size_t)(n * 256 + d0 + dd) * 256 + kc * 8); }
#pragma unroll
                    for (int k = 0; k < 3; ++k) { const int i = tid + k * NTHREADS, ic = i < 1280 ? i : 1279, tp = ic >> 8, c = ic & 255;
                        const float* src = (tp < 4) ? a.conv_w + tp * DM + n * 256 + c : a.conv_b + n * 256 + c; ctmp[k] = *src; }
                    { const int ch = cb + (tid & 31); gtmp[0] = a.lru_lambda[ch]; gtmp[1] = a.lru_ba[ch]; gtmp[2] = a.lru_bi[ch]; }
#pragma unroll
                    for (int k = 0; k < 4; ++k) { const int i = tid + k * NTHREADS, gate = i >> 10, dd = (i >> 5) & 31, kc = i & 31;
                        *(LAS u32x4*)(lds + WL_OFF + (gate * 32 + dd) * AT_STRIDE + kc * 16) = wtmp[k]; }
#pragma unroll
                    for (int k = 0; k < 3; ++k) { const int i = tid + k * NTHREADS; if (i < 1280) ((LAS float*)(lds + CW_OFF))[i] = ctmp[k]; }
                    if (tid < 32) { const float lam = gtmp[0];
                        ((LAS float*)(lds + GC_OFF))[tid] = (lam > 15.f) ? __expf(-lam) : log1pf(__expf(-lam)); ((LAS float*)(lds + GC_OFF))[32 + tid] = gtmp[1]; ((LAS float*)(lds + GC_OFF))[64 + tid] = gtmp[2]; }
                    if (tid < 64) ((LAS float*)(lds + CARRY_OFF))[tid] = 0.f;
                }
                __syncthreads();
                const u32x4 zero4 = (u32x4){0u, 0u, 0u, 0u};
                const int sch0 = tid & 31, seg0 = seg, fr0 = fr, fq0 = fq, cg80 = cg8;
#define LRU_LOAD_ROWS(TI) do { const bf16_t* base_ = LX + ((long)(b * 2064 + ((TI) == 0 ? 0 : 16 + ((TI) - 1) * 128) + seg * 8 - 3)) * DM + cch; \
                    _Pragma("unroll") for (int q_ = 0; q_ < 11; ++q_) { const bool ok_ = !((TI) == 0 && seg == 0 && q_ < 3); lxr[q_] = zero4; if (ok_) lxr[q_] = *(const u32x4*)(base_ + (long)q_ * DM); } } while (0)
                u32x4 lxr[11];
                LRU_LOAD_ROWS(0);
#pragma unroll 1
                for (int ti = 0; ti < 17; ++ti) {
                    int seg = seg0, sch = sch0, fr = fr0, fq = fq0, cg8 = cg80;
                    asm volatile("" : "+v"(seg), "+v"(sch), "+v"(fr), "+v"(fq), "+v"(cg8));
                    {
                        f32x2 win[3][4], cw[4][4], cbias[4];
#pragma unroll
                        for (int p = 0; p < 4; ++p) { win[0][p] = (f32x2){0.f, 0.f}; win[1][p] = (f32x2){0.f, 0.f}; win[2][p] = (f32x2){0.f, 0.f}; }
#pragma unroll
                        for (int tp = 0; tp < 5; ++tp) { const f32x4 c0 = *(const LAS f32x4*)(lds + CW_OFF + (tp * 256 + cg8 * 8) * 4), c1 = *(const LAS f32x4*)(lds + CW_OFF + (tp * 256 + cg8 * 8 + 4) * 4);
                            if (tp < 4) { cw[tp & 3][0] = (f32x2){c0[0], c0[1]}; cw[tp & 3][1] = (f32x2){c0[2], c0[3]}; cw[tp & 3][2] = (f32x2){c1[0], c1[1]}; cw[tp & 3][3] = (f32x2){c1[2], c1[3]}; }
                            else { cbias[0] = (f32x2){c0[0], c0[1]}; cbias[1] = (f32x2){c0[2], c0[3]}; cbias[2] = (f32x2){c1[0], c1[1]}; cbias[3] = (f32x2){c1[2], c1[3]}; } }
#pragma unroll
                        for (int q = 0; q < 11; ++q) {
                            const u32x4 w = lxr[q];
                            const f32x2 cur[4] = {(f32x2){bf_lo(w.x), bf_hi(w.x)}, (f32x2){bf_lo(w.y), bf_hi(w.y)}, (f32x2){bf_lo(w.z), bf_hi(w.z)}, (f32x2){bf_lo(w.w), bf_hi(w.w)}};
                            if (q >= 3) {
                                f32x2 y[4];
#pragma unroll
                                for (int p = 0; p < 4; ++p) y[p] = __builtin_elementwise_fma(cur[p], cw[3][p], __builtin_elementwise_fma(win[2][p], cw[2][p], __builtin_elementwise_fma(win[1][p], cw[1][p], __builtin_elementwise_fma(win[0][p], cw[0][p], cbias[p]))));
                                u32x4 o; o.x = cvt_pk_bf16(y[0][0], y[0][1]); o.y = cvt_pk_bf16(y[1][0], y[1][1]); o.z = cvt_pk_bf16(y[2][0], y[2][1]); o.w = cvt_pk_bf16(y[3][0], y[3][1]);
                                *(LAS u32x4*)(lds + (seg * 8 + q - 3) * AT_STRIDE + cg8 * 16) = o;
                            }
#pragma unroll
                            for (int p = 0; p < 4; ++p) { win[0][p] = win[1][p]; win[1][p] = win[2][p]; win[2][p] = cur[p]; }
                        }
                    }
                    const size_t row0 = (size_t)(b * SEQ + (ti > 0 ? ti - 1 : 0) * 128 + 8 * seg);
                    unsigned lgv[8];
                    { const bf16_t* lgp = LG + row0 * DM + cb + sch;
#pragma unroll
                      for (int j = 0; j < 8; ++j) lgv[j] = lgp[(size_t)j * DM]; }
                    { const int tn = ti < 16 ? ti + 1 : 16; LRU_LOAD_ROWS(tn); }
                    WG_BAR();
                    {
                        f32x4 acc[2][2];
#pragma unroll
                        for (int gt = 0; gt < 2; ++gt)
#pragma unroll
                            for (int nt = 0; nt < 2; ++nt) acc[gt][nt] = (f32x4){0.f, 0.f, 0.f, 0.f};
#pragma unroll
                        for (int ks = 0; ks < 8; ++ks) {
                            const bf16x8 af = *(const LAS bf16x8*)(lds + (16 * wave + fr) * AT_STRIDE + ks * 64 + fq * 16);
#pragma unroll
                            for (int gt = 0; gt < 2; ++gt)
#pragma unroll
                                for (int nt = 0; nt < 2; ++nt) {
                                    const bf16x8 wf = *(const LAS bf16x8*)(lds + WL_OFF + (gt * 32 + 16 * nt + fr) * AT_STRIDE + ks * 64 + fq * 16);
                                    acc[gt][nt] = __builtin_amdgcn_mfma_f32_16x16x32_bf16(wf, af, acc[gt][nt], 0, 0, 0);
                                }
                        }
                        const int tk = 16 * wave + fr;
#pragma unroll
                        for (int nt = 0; nt < 2; ++nt)
#pragma unroll
                            for (int r = 0; r < 4; ++r) {
                                const int ch = 16 * nt + 4 * fq + r;
                                const float splv = ((LAS float*)(lds + GC_OFF))[ch], bavv = ((LAS float*)(lds + GC_OFF))[32 + ch], bivv = ((LAS float*)(lds + GC_OFF))[64 + ch];
                                const float rg = fast_sigmoid(acc[0][nt][r] + bavv), ig = fast_sigmoid(acc[1][nt][r] + bivv);
                                const float la = -8.0f * rg * splv;
                                const float av = __builtin_amdgcn_exp2f(la * LOG2E);
                                const float t2 = 2.0f * la;
                                const float m2s = -t2 * (1.0f + t2 * (0.5f + t2 * (0.16666667f + t2 * (0.041666668f + t2 * (0.0083333338f + t2 * 0.0013888889f)))));
                                const float m2 = (t2 > -0.25f) ? m2s : (1.0f - av * av);
                                float mult = __builtin_amdgcn_sqrtf(fmaxf(m2, 0.f));
                                if (ti == 0 && tk == 0) mult = 1.0f;
                                const float xv = bf2f(*(const LAS bf16_t*)(lds + tk * AT_STRIDE + (d0 + ch) * 2));
                                ((LAS float*)(lds + AB_OFF))[ch * ABS + tk] = av;
                                ((LAS float*)(lds + BB_OFF))[ch * ABS + tk] = mult * ig * xv;
                            }
                    }
                    WG_BAR();
                    {
                        float A = 1.f, H = 0.f;
#pragma unroll
                        for (int j = 0; j < 8; ++j) { const float av = ((LAS float*)(lds + AB_OFF))[sch * ABS + 8 * seg + j], bv = ((LAS float*)(lds + BB_OFF))[sch * ABS + 8 * seg + j]; H = av * H + bv; A *= av; }
                        ((LAS f32x2*)(lds + SEG_OFF))[seg * 32 + sch] = (f32x2){A, H};
                    }
                    WG_BAR();
                    {
#pragma unroll
                        for (int j = 0; j < 8; ++j) asm volatile("" : "+v"(lgv[j]));
                        float hst = ((LAS float*)(lds + CARRY_OFF))[(ti & 1) * 32 + sch];
                        f32x2 shs[15];
#pragma unroll
                        for (int s2 = 0; s2 < 15; ++s2) shs[s2] = ((LAS f32x2*)(lds + SEG_OFF))[s2 * 32 + sch];
#pragma unroll
                        for (int s2 = 0; s2 < 15; ++s2) hst = (s2 < seg) ? shs[s2].x * hst + shs[s2].y : hst;
#pragma unroll
                        for (int j = 0; j < 8; ++j) { const float av = ((LAS float*)(lds + AB_OFF))[sch * ABS + 8 * seg + j], bv = ((LAS float*)(lds + BB_OFF))[sch * ABS + 8 * seg + j]; hst = av * hst + bv;
                            if (ti > 0) REC[(row0 + j) * DM + cb + sch] = (bf16_t)(cvt_pk_bf16(__uint_as_float(lgv[j] << 16) * hst, 0.f) & 0xffffu); }
                        const int lastseg = (ti == 0) ? 1 : 15;
                        if (seg == lastseg) ((LAS float*)(lds + CARRY_OFF))[((ti + 1) & 1) * 32 + sch] = hst;
                    }
                }
#undef LRU_LOAD_ROWS
                __syncthreads();
            }
        }
    }
    SEAM(4);

    if (IN(5)) {
        SchedMix S{(const char*)Ob, (const char*)REC, (const char*)Wt_oa, (const char*)Wt_ol, G, bid};
        EpiMix E{GA, GL, MIX};
        pg8::gemm_phase<EpiMix, SchedMix, true>(lds, 2 * DM, S, E);
    }
    SEAM(5);

    if (IN(6)) {
        SchedPlain S{(const char*)MIX, (const char*)Wt_out, 32, 8, DM, G, bid};
        EpiRes E{a.x, a.norm2_g, a.out, HG, rowss, a.flags & 1};
        pg8::gemm_phase<EpiRes, SchedPlain>(lds, DM, S, E);
    }
    SEAM(6);

    if (IN(7)) {
        SchedPlain S{(const char*)HG, (const char*)Wt_up, 32, 32, DM, G, bid};
        EpiUp E{rowss, U};
        pg8::gemm_phase<EpiUp, SchedPlain>(lds, DM, S, E);
    }
    SEAM(7);

    if (IN(8)) {
        SchedPlain S{(const char*)U, (const char*)Wt_dn, 32, 8, FF, G, bid};
        EpiDown E{a.out, a.flags & 2};
        pg8::gemm_phase<EpiDown, SchedPlain>(lds, FF, S, E);
    }
#undef IN
#undef SEAM
}

extern "C" void kernel_launch(void* const* d_in, const int* in_sizes, int n_in, void* d_out, int out_size, void* d_ws, size_t ws_size, hipStream_t stream) {
    static int grid = 0;
    if (grid == 0) {
        if (n_in != 20 || ws_size < WS_END) { fprintf(stderr, "kernel_launch: unexpected inputs (n_in %d, ws %zu)\n", n_in, ws_size); grid = -1; return; }
        int dev = 0, cus = 0, per_cu = 0;
        hipGetDevice(&dev);
        hipDeviceGetAttribute(&cus, hipDeviceAttributeMultiprocessorCount, dev);
        if (hipFuncSetAttribute((const void*)fwd_kernel, hipFuncAttributeMaxDynamicSharedMemorySize, LDS_BYTES) != hipSuccess) { fprintf(stderr, "kernel_launch: hipFuncSetAttribute failed\n"); grid = -1; return; }
        if (hipOccupancyMaxActiveBlocksPerMultiprocessor(&per_cu, (const void*)fwd_kernel, NTHREADS, LDS_BYTES) != hipSuccess || per_cu < 1) { fprintf(stderr, "kernel_launch: occupancy query says %d\n", per_cu); per_cu = 1; }
        (void)hipGetLastError();
        grid = cus * per_cu;
    }
    if (grid < 0) return;
    Args a{};
    a.x = (const float*)d_in[0]; a.meta = (const float*)d_in[1]; a.norm1_g = (const float*)d_in[2]; a.w_in = (const float*)d_in[3];
    a.q_norm_g = (const float*)d_in[4]; a.k_norm_g = (const float*)d_in[5]; a.sinks = (const float*)d_in[6]; a.w_o_attn = (const float*)d_in[7];
    a.conv_w = (const float*)d_in[8]; a.conv_b = (const float*)d_in[9]; a.lru_wa = (const float*)d_in[10]; a.lru_ba = (const float*)d_in[11];
    a.lru_wi = (const float*)d_in[12]; a.lru_bi = (const float*)d_in[13]; a.lru_lambda = (const float*)d_in[14]; a.w_o_lru = (const float*)d_in[15];
    a.w_out = (const float*)d_in[16]; a.norm2_g = (const float*)d_in[17]; a.w_up = (const float*)d_in[18]; a.w_down = (const float*)d_in[19];
    a.out = (float*)d_out; a.ws = (unsigned char*)d_ws;
    if (hipMemsetAsync((unsigned char*)d_ws + WS_BAR, 0, WS_BAR_BYTES, stream) != hipSuccess) { fprintf(stderr, "kernel_launch: memset of the barrier words failed\n"); return; }
#if MK_MULTI
    for (int ph = 0; ph < 9; ++ph) {
        a.ph_lo = ph; a.ph_hi = ph + 1; a.flags = 0;
        void* args[] = {&a};
        hipError_t e = hipLaunchCooperativeKernel((const void*)fwd_kernel, dim3(grid), dim3(NTHREADS), args, LDS_BYTES, stream);
        if (e != hipSuccess) { fprintf(stderr, "cooperative launch (phase %d) failed: %s (grid %d)\n", ph, hipGetErrorString(e), grid); break; }
    }
#elif PROBE_DUP >= 0
    for (int li = 0; li < 2; ++li) {
        a.ph_lo = li ? PROBE_DUP : 0; a.ph_hi = li ? 9 : PROBE_DUP + 1; a.flags = (li << 8) | (li ? 0 : (PROBE_DUP == 6 ? 1 : (PROBE_DUP == 8 ? 2 : 0)));
        void* args[] = {&a};
        hipError_t e = hipLaunchCooperativeKernel((const void*)fwd_kernel, dim3(grid), dim3(NTHREADS), args, LDS_BYTES, stream);
        if (e != hipSuccess) { fprintf(stderr, "cooperative launch failed: %s (grid %d)\n", hipGetErrorString(e), grid); break; }
    }
#else
    a.ph_lo = 0; a.ph_hi = 9;
    void* args[] = {&a};
    hipError_t e = hipLaunchCooperativeKernel((const void*)fwd_kernel, dim3(grid), dim3(NTHREADS), args, LDS_BYTES, stream);
    if (e != hipSuccess) fprintf(stderr, "cooperative launch failed: %s (grid %d)\n", hipGetErrorString(e), grid);
#endif
}
```

```cpp
#include <hip/hip_runtime.h>
#include <hip/hip_cooperative_groups.h>
#include <cstdio>
#include <cstdint>
namespace cg = cooperative_groups;

#ifndef MK_MULTI
#define MK_MULTI 0
#endif

#ifndef PROBE_DUP
#define PROBE_DUP -1
#endif

#define LAS __attribute__((address_space(3)))
typedef unsigned short bf16_t;
typedef short bf16x8 __attribute__((ext_vector_type(8)));
typedef float f32x4 __attribute__((ext_vector_type(4)));
typedef float f32x2 __attribute__((ext_vector_type(2)));
typedef unsigned u32x4 __attribute__((ext_vector_type(4)));
typedef unsigned u32x2 __attribute__((ext_vector_type(2)));

constexpr int DM = 2048, NBATCH = 4, SEQ = 2048, MR = NBATCH * SEQ  , NMETA = 16, MPAD = 8448  ;
constexpr int INW = 10752, FF = 8192, KVW = 256;
constexpr float EPS = 1e-6f;
constexpr float LOG2E = 1.4426950408889634f;
constexpr int NTHREADS = 512, NWAVES = 8;
constexpr int LDS_BYTES = 147456;

constexpr size_t MiB = 1u << 20;
constexpr size_t WS_CTL = 0;
constexpr size_t WS_BAR = 65536, WS_BAR_BYTES = 65536;
constexpr size_t WS_R1 = 1 * MiB;
constexpr size_t WS_WTIN = WS_R1, WS_XN = WS_R1 + 42 * MiB;
constexpr size_t WS_WTUP = 272 * MiB, WS_WTDN = 304 * MiB;
constexpr size_t WS_WOA = 76 * MiB, WS_WOL = 84 * MiB, WS_WOUT = 92 * MiB, WS_WA = 100 * MiB, WS_WI = 101 * MiB;
constexpr size_t WS_Q = 102 * MiB;
constexpr size_t WS_K = 134 * MiB, WS_V = 134 * MiB + 4608 * 1024;
constexpr size_t WS_LX = 143 * MiB;
constexpr size_t WS_LG = 176 * MiB;
constexpr size_t WS_GA = 208 * MiB, WS_GL = 240 * MiB;
constexpr size_t WS_U = 143 * MiB;
#if PROBE_DUP == 3 || PROBE_DUP == 4
constexpr size_t WS_O = WS_R1, WS_REC = WS_R1 + 32 * MiB;
#else
constexpr size_t WS_O = WS_Q, WS_REC = WS_LG;
#endif
constexpr size_t WS_END = 336 * MiB;

typedef __bf16 bf16x2_t __attribute__((ext_vector_type(2)));
__device__ __forceinline__ unsigned cvt_pk_bf16(float lo, float hi) { const f32x2 v = {lo, hi}; const bf16x2_t b = __builtin_convertvector(v, bf16x2_t); return __builtin_bit_cast(unsigned, b); }
__device__ __forceinline__ float bf_lo(unsigned w) { return __uint_as_float(w << 16); }
__device__ __forceinline__ float bf_hi(unsigned w) { return __uint_as_float(w & 0xffff0000u); }
__device__ __forceinline__ float bf2f(bf16_t u) { return __uint_as_float((unsigned)u << 16); }
__device__ __forceinline__ float fast_sigmoid(float x) { return __builtin_amdgcn_rcpf(1.0f + __builtin_amdgcn_exp2f(-x * LOG2E)); }
__device__ __forceinline__ float gelu_tanh(float x) { const float y = 0.7978845608028654f * (x + 0.044715f * x * x * x); return x * __builtin_amdgcn_rcpf(1.0f + __builtin_amdgcn_exp2f(-2.0f * LOG2E * y)); }
#define LDS_WAIT() asm volatile("s_waitcnt lgkmcnt(0)" ::: "memory")
#define WG_BAR() do { asm volatile("s_waitcnt lgkmcnt(0)" ::: "memory"); __builtin_amdgcn_s_barrier(); asm volatile("" ::: "memory"); } while (0)

namespace pg8 {
constexpr int BM = 256, BK = 64, HALF = 128, HTB = HALF * BK * 2, STAGE_BYTES = 8 * HTB, NXCD = 8, WGM = 8;
__host__ __device__ __forceinline__ int lds_byte(int r, int c) { const int st = (r >> 4) * 2 + (c >> 5), rr = r & 15, cc = c & 31, ob = rr * 64 + cc * 2; return st * 1024 + (ob ^ (((ob >> 9) & 1) << 5)); }
__host__ __device__ __forceinline__ void stage_rc(int b, int& R, int& C) { const int st = b / 1024, sb = b % 1024, swz = sb ^ (((sb >> 9) & 1) << 5); R = (st >> 1) * 16 + swz / 64; C = (st & 1) * 32 + (swz % 64) / 2; }
__host__ __device__ __forceinline__ int perm32(int rho) { const int n = rho >> 4, i = rho & 15; return 8 * (i >> 2) + 4 * n + (i & 3); }

struct Unit { int pm, pn, sub; };

__device__ __forceinline__ void tile_of(int wgid, int nM, int nN, Unit& u) {
    const int nwg = nM * nN;
    { const int q = nwg / NXCD, r = nwg % NXCD, xcd = wgid % NXCD, off = wgid / NXCD; wgid = (xcd < r ? xcd * (q + 1) : r * (q + 1) + (xcd - r) * q) + off; }
    const int nig = WGM * nN, gid = wgid / nig, fm = gid * WGM, gsz = (nM - fm) < WGM ? (nM - fm) : WGM;
    u.pm = fm + ((wgid % nig) % gsz); u.pn = (wgid % nig) / gsz; u.sub = 0;
}

template <class Epi, class Sched, bool SPLITK = false>
__device__ __forceinline__ void gemm_phase(LAS unsigned char* lds, const int K, const Sched& S, const Epi& E) {
    const int tid = threadIdx.x, wid = __builtin_amdgcn_readfirstlane(tid >> 6), lane = tid & 63, wr = wid >> 2, wc = wid & 3, fr = lane & 15, fq = lane >> 4;
    const int nt = K / BK, nth = nt / 2, ld = SPLITK ? K / 2 : K;
    unsigned voffA[2], voffB[2];
#pragma unroll
    for (int i = 0; i < 2; ++i) { int R, C; stage_rc(tid * 16 + i * 8192, R, C); const int Rb = Epi::PERM ? ((R & ~31) + perm32(R & 31)) : R;
        voffA[i] = (unsigned)(R * ld + C) * 2u; voffB[i] = (unsigned)(Rb * ld + C) * 2u; }
    const size_t kstep = (size_t)(BK * 2);
    const size_t hstep = (size_t)HALF * ld * 2;
    const unsigned ldsw = (unsigned)wid * 1024u;
    const int aoff = lds_byte(wr * 64 + fr, fq * 8), boff = lds_byte(wc * 32 + fr, fq * 8);
#define PG8_SA(b, h) (((b) * 2 + (h)) * HTB)
#define PG8_SB(b, h) ((4 + (b) * 2 + (h)) * HTB)
#define PG8_STAGE(bufoff, gbase, voff) do { _Pragma("unroll") for (int _i = 0; _i < 2; ++_i) \
        __builtin_amdgcn_global_load_lds((const unsigned*)((const char*)(gbase) + (voff)[_i]), (LAS unsigned*)(lds + (bufoff) + ldsw + _i * 8192), 16, 0, 0); } while (0)
#define PG8_LDA(dst, b, h) do { _Pragma("unroll") for (int m = 0; m < 4; ++m) _Pragma("unroll") for (int k = 0; k < 2; ++k) dst[m][k] = *(const LAS bf16x8*)(lds + PG8_SA(b, h) + aoff + m * 2048 + k * 1024); } while (0)
#define PG8_LDB(dst, b, h) do { _Pragma("unroll") for (int n = 0; n < 2; ++n) _Pragma("unroll") for (int k = 0; k < 2; ++k) dst[n][k] = *(const LAS bf16x8*)(lds + PG8_SB(b, h) + boff + n * 2048 + k * 1024); } while (0)
#define PG8_MMA(ai, bj, At, Bt) do { __builtin_amdgcn_s_setprio(1); _Pragma("unroll") for (int m = 0; m < 4; ++m) _Pragma("unroll") for (int n = 0; n < 2; ++n) _Pragma("unroll") for (int k = 0; k < 2; ++k) \
        acc[ai][bj][m][n] = __builtin_amdgcn_mfma_f32_16x16x32_bf16(Bt[n][k], At[m][k], acc[ai][bj][m][n], 0, 0, 0); __builtin_amdgcn_s_setprio(0); } while (0)
#define PG8_WAIT_V(n) asm volatile("s_waitcnt vmcnt(" #n ")" ::: "memory")
#define PG8_WAIT_L(n) asm volatile("s_waitcnt lgkmcnt(" #n ")" ::: "memory")
#define PG8_BAR __builtin_amdgcn_s_barrier()
#define PG8_SCHED __builtin_amdgcn_sched_barrier(0)
    Unit cur, nxt; int ui = 0;
    if (!S.next(0, cur)) return;
    f32x4 acc[2][2][4][2];
    E.init(acc, cur, wr, wc, fr, fq);
    bf16x8 At[4][2], B0[2][2], B1[2][2];
    const char* cA = S.a_base(cur); const char* cB = S.b_base(cur);
    const char* cA2 = cA; const char* cB2 = cB;
    if constexpr (SPLITK) { cA2 = S.a_base2(cur); cB2 = S.b_base2(cur); }
#define PG8_KTA(j) ((SPLITK && (j) >= nth) ? cA2 + (size_t)((j) - nth) * kstep : cA + (size_t)(j) * kstep)
#define PG8_KTB(j) ((SPLITK && (j) >= nth) ? cB2 + (size_t)((j) - nth) * kstep : cB + (size_t)(j) * kstep)
    PG8_STAGE(PG8_SB(0, 0), cB, voffB); PG8_STAGE(PG8_SB(0, 1), cB + hstep, voffB); PG8_STAGE(PG8_SA(0, 0), cA, voffA); PG8_STAGE(PG8_SA(0, 1), cA + hstep, voffA);
    if (wr == 1) PG8_BAR;
    PG8_WAIT_V(2); PG8_BAR;
    PG8_STAGE(PG8_SB(1, 0), cB + kstep, voffB); PG8_STAGE(PG8_SA(1, 0), cA + kstep, voffA); PG8_STAGE(PG8_SB(1, 1), cB + hstep + kstep, voffB);
    PG8_WAIT_V(6); PG8_BAR;
    for (;;) {
        const bool has_next = S.next(ui + 1, nxt);
        const char* nA = has_next ? S.a_base(nxt) : cA; const char* nB = has_next ? S.b_base(nxt) : cB;
        for (int t = 0; t < nt; t += 2) {
            const bool last = (t == nt - 2);
            const char* a1 = PG8_KTA(t + 1);
            const char* a2 = last ? nA : PG8_KTA(t + 2); const char* b2 = last ? nB : PG8_KTB(t + 2);
            const char* a3 = last ? nA + kstep : PG8_KTA(t + 3); const char* b3 = last ? nB + kstep : PG8_KTB(t + 3);
            if constexpr (SPLITK) { if (t == nth) E.mid(acc, cur, wr, wc, fr, fq); }
            PG8_LDB(B0, 0, 0); PG8_LDB(B1, 0, 1); PG8_SCHED; PG8_LDA(At, 0, 0); PG8_STAGE(PG8_SA(1, 1), a1 + hstep, voffA);
            PG8_WAIT_V(8); PG8_WAIT_L(0); PG8_BAR; PG8_MMA(0, 0, At, B0); PG8_MMA(0, 1, At, B1); PG8_BAR; PG8_SCHED;
            PG8_LDA(At, 0, 1); PG8_STAGE(PG8_SB(0, 0), b2, voffB); PG8_STAGE(PG8_SB(0, 1), b2 + hstep, voffB); PG8_STAGE(PG8_SA(0, 0), a2, voffA);
            PG8_WAIT_V(8); PG8_WAIT_L(0); PG8_BAR; PG8_MMA(1, 0, At, B0); PG8_MMA(1, 1, At, B1); PG8_BAR; PG8_SCHED;
            PG8_LDB(B0, 1, 0); PG8_LDB(B1, 1, 1); PG8_SCHED; PG8_LDA(At, 1, 0); PG8_STAGE(PG8_SA(0, 1), a2 + hstep, voffA);
            PG8_WAIT_V(8); PG8_WAIT_L(0); PG8_BAR; PG8_MMA(0, 0, At, B0); PG8_MMA(0, 1, At, B1); PG8_BAR; PG8_SCHED;
            PG8_LDA(At, 1, 1); PG8_STAGE(PG8_SB(1, 0), b3, voffB); PG8_STAGE(PG8_SB(1, 1), b3 + hstep, voffB); PG8_STAGE(PG8_SA(1, 0), a3, voffA);
            PG8_WAIT_V(8); PG8_WAIT_L(0); PG8_BAR; PG8_MMA(1, 0, At, B0); PG8_MMA(1, 1, At, B1); PG8_BAR; PG8_SCHED;
        }
        if (wr == 0) PG8_BAR;
        E(acc, cur, wr, wc, fr, fq);
        if (!has_next) break;
        E.init(acc, nxt, wr, wc, fr, fq);
        cur = nxt; cA = nA; cB = nB; ++ui;
        if constexpr (SPLITK) { cA2 = S.a_base2(cur); cB2 = S.b_base2(cur); }
        if (wr == 1) PG8_BAR;
    }
    PG8_WAIT_V(0);
    PG8_BAR;
#undef PG8_KTA
#undef PG8_KTB
#undef PG8_SA
#undef PG8_SB
#undef PG8_STAGE
#undef PG8_LDA
#undef PG8_LDB
#undef PG8_MMA
#undef PG8_WAIT_V
#undef PG8_WAIT_L
#undef PG8_BAR
#undef PG8_SCHED
}
}
using pg8::Unit;

struct SchedIn {
    const char* A; const char* B; int G, c;
    __device__ __forceinline__ bool next(int i, Unit& u) const {
        const int L = i * G + c; constexpr int NREG = 32 * 42;
        if (L < NREG) { pg8::tile_of(L, 32, 42, u); return true; }
        if (L < NREG + 10) { u.pm = 32; u.pn = 8 + (L - NREG); u.sub = 0; return true; }
        return false;
    }
    __device__ __forceinline__ const char* a_base(const Unit& u) const { return A + (size_t)u.pm * (256u * DM * 2u); }
    __device__ __forceinline__ const char* b_base(const Unit& u) const { return B + (size_t)u.pn * (256u * DM * 2u); }
};
struct SchedMix {
    const char* A0; const char* A1; const char* B0; const char* B1; int G, c;
    __device__ __forceinline__ bool next(int i, Unit& u) const {
        const int L = i * G + c; if (L >= 32 * 8) return false;
        pg8::tile_of(L, 32, 8, u); return true;
    }
    __device__ __forceinline__ const char* a_base(const Unit& u) const { return A0 + (size_t)u.pm * (256u * DM * 2u); }
    __device__ __forceinline__ const char* b_base(const Unit& u) const { return B0 + (size_t)u.pn * (256u * DM * 2u); }
    __device__ __forceinline__ const char* a_base2(const Unit& u) const { return A1 + (size_t)u.pm * (256u * DM * 2u); }
    __device__ __forceinline__ const char* b_base2(const Unit& u) const { return B1 + (size_t)u.pn * (256u * DM * 2u); }
};
struct SchedPlain {
    const char* A; const char* B; int nM, nN, K, G, c;
    __device__ __forceinline__ bool next(int i, Unit& u) const {
        const int L = i * G + c; if (L >= nM * nN) return false;
        pg8::tile_of(L, nM, nN, u); return true;
    }
    __device__ __forceinline__ const char* a_base(const Unit& u) const { return A + (size_t)u.pm * 256u * (size_t)K * 2u; }
    __device__ __forceinline__ const char* b_base(const Unit& u) const { return B + (size_t)u.pn * 256u * (size_t)K * 2u; }
};

__device__ __forceinline__ void acc_zero(f32x4 (&acc)[2][2][4][2]) {
#pragma unroll
    for (int a = 0; a < 2; ++a)
#pragma unroll
        for (int b = 0; b < 2; ++b)
#pragma unroll
            for (int m = 0; m < 4; ++m)
#pragma unroll
                for (int n = 0; n < 2; ++n) acc[a][b][m][n] = (f32x4){0.f, 0.f, 0.f, 0.f};
}
#define EPI_ZERO_INIT __device__ __forceinline__ void init(f32x4 (&acc)[2][2][4][2], const Unit&, int, int, int, int) const { acc_zero(acc); }
__device__ __forceinline__ void acc_load_f32(f32x4 (&acc)[2][2][4][2], const float* src, const Unit& u, int wr, int wc, int fr, int fq) {
    const int row0 = u.pm * 256 + wr * 64 + fr, col0 = u.pn * 256 + wc * 32 + 4 * fq;
#pragma unroll
    for (int ai = 0; ai < 2; ++ai)
#pragma unroll
        for (int m = 0; m < 4; ++m) { const size_t off = (size_t)(row0 + ai * 128 + m * 16) * DM + col0;
#pragma unroll
            for (int bj = 0; bj < 2; ++bj)
#pragma unroll
                for (int n = 0; n < 2; ++n) acc[ai][bj][m][n] = __builtin_nontemporal_load((const f32x4*)(src + off + bj * 128 + n * 16)); }
}
struct EpiIn {
    static constexpr bool PERM = true;
    bf16_t *Q, *Kb, *Vb, *LX, *LG, *GA, *GL;
    EPI_ZERO_INIT
    __device__ __forceinline__ void operator()(const f32x4 (&acc)[2][2][4][2], const Unit& u, int wr, int wc, int fr, int fq) const {
        const int pn = u.pn; int mode = 0, ldc = DM, colt; bf16_t* base;
        if (pn < 8) { base = Q; colt = pn * 256; }
        else if (pn == 8) { base = Kb; ldc = KVW; colt = 0; }
        else if (pn == 9) { base = Vb; ldc = KVW; colt = 0; }
        else if (pn < 18) { base = LX; colt = (pn - 10) * 256; }
        else if (pn < 26) { base = LG; colt = (pn - 18) * 256; mode = 1; }
        else {
            const int row0g = u.pm * 256 + wr * 64 + fr, ch0 = (pn - 26) * 128 + wc * 32 + 8 * fq;
#pragma unroll
            for (int ai = 0; ai < 2; ++ai)
#pragma unroll
                for (int m = 0; m < 4; ++m) { const size_t off = (size_t)(row0g + ai * 128 + m * 16) * DM + ch0;
                    float sr[8], sl[8];
#pragma unroll
                    for (int e = 0; e < 4; ++e) { const float a0 = fast_sigmoid(acc[ai][0][m][0][e]), a1 = fast_sigmoid(acc[ai][0][m][1][e]); sl[e] = fast_sigmoid(acc[ai][1][m][0][e]); sl[4 + e] = fast_sigmoid(acc[ai][1][m][1][e]);
                        sr[e] = a0 * __builtin_amdgcn_rcpf(fmaxf(sl[e], 1e-30f)); sr[4 + e] = a1 * __builtin_amdgcn_rcpf(fmaxf(sl[4 + e], 1e-30f)); }
                    u32x4 wr4, wl4;
                    wr4.x = cvt_pk_bf16(sr[0], sr[1]); wr4.y = cvt_pk_bf16(sr[2], sr[3]); wr4.z = cvt_pk_bf16(sr[4], sr[5]); wr4.w = cvt_pk_bf16(sr[6], sr[7]);
                    wl4.x = cvt_pk_bf16(sl[0], sl[1]); wl4.y = cvt_pk_bf16(sl[2], sl[3]); wl4.z = cvt_pk_bf16(sl[4], sl[5]); wl4.w = cvt_pk_bf16(sl[6], sl[7]);
                    __builtin_nontemporal_store(wr4, (u32x4*)(GA + off)); __builtin_nontemporal_store(wl4, (u32x4*)(GL + off)); }
            return;
        }
        const int row0 = u.pm * 256 + wr * 64 + fr, col0 = colt + wc * 32 + 8 * fq;
        const bool islx = (pn >= 10 && pn < 18);
#pragma unroll
        for (int ai = 0; ai < 2; ++ai)
#pragma unroll
            for (int m = 0; m < 4; ++m) { const int row = row0 + ai * 128 + m * 16; int orow = row;
                if (islx) orow = (row < MR) ? row + 16 * ((row >> 11) + 1) : row - MR;
                bf16_t* rowp = base + (size_t)orow * ldc + col0;
                const bool metarow = islx && row >= MR; if (metarow && row >= MR + NMETA) continue;
#pragma unroll
                for (int bj = 0; bj < 2; ++bj) { f32x4 v0 = acc[ai][bj][m][0], v1 = acc[ai][bj][m][1];
                    if (mode == 1) {
#pragma unroll
                        for (int e = 0; e < 4; ++e) { v0[e] = gelu_tanh(v0[e]); v1[e] = gelu_tanh(v1[e]); } }
                    else if (mode == 2) {
#pragma unroll
                        for (int e = 0; e < 4; ++e) { v0[e] = fast_sigmoid(v0[e]); v1[e] = fast_sigmoid(v1[e]); } }
                    u32x4 w; w.x = cvt_pk_bf16(v0[0], v0[1]); w.y = cvt_pk_bf16(v0[2], v0[3]); w.z = cvt_pk_bf16(v1[0], v1[1]); w.w = cvt_pk_bf16(v1[2], v1[3]);
                    *(u32x4*)(rowp + bj * 128) = w;
                    if (metarow) { *(u32x4*)(rowp + (size_t)2064 * DM + bj * 128) = w; *(u32x4*)(rowp + (size_t)(2 * 2064) * DM + bj * 128) = w; *(u32x4*)(rowp + (size_t)(3 * 2064) * DM + bj * 128) = w; } } }
    }
};
struct EpiMix {
    static constexpr bool PERM = true;
    const bf16_t *GA, *GL; bf16_t* MIX;
    EPI_ZERO_INIT
    __device__ __forceinline__ void mid(f32x4 (&acc)[2][2][4][2], const Unit& u, int wr, int wc, int fr, int fq) const {
        const int row0 = u.pm * 256 + wr * 64 + fr, col0 = u.pn * 256 + wc * 32 + 8 * fq;
#pragma unroll
        for (int ai = 0; ai < 2; ++ai)
#pragma unroll
            for (int m = 0; m < 4; ++m) { const size_t off = (size_t)(row0 + ai * 128 + m * 16) * DM + col0;
#pragma unroll
                for (int bj = 0; bj < 2; ++bj) { const u32x4 aw = __builtin_nontemporal_load((const u32x4*)(GA + off + bj * 128));
                    const float ra[8] = {bf_lo(aw.x), bf_hi(aw.x), bf_lo(aw.y), bf_hi(aw.y), bf_lo(aw.z), bf_hi(aw.z), bf_lo(aw.w), bf_hi(aw.w)};
#pragma unroll
                    for (int e = 0; e < 4; ++e) { acc[ai][bj][m][0][e] *= ra[e]; acc[ai][bj][m][1][e] *= ra[4 + e]; } } }
    }
    __device__ __forceinline__ void operator()(const f32x4 (&acc)[2][2][4][2], const Unit& u, int wr, int wc, int fr, int fq) const {
        const int row0 = u.pm * 256 + wr * 64 + fr, col0 = u.pn * 256 + wc * 32 + 8 * fq;
#pragma unroll
        for (int ai = 0; ai < 2; ++ai)
#pragma unroll
            for (int m = 0; m < 4; ++m) { const size_t off = (size_t)(row0 + ai * 128 + m * 16) * DM + col0;
#pragma unroll
                for (int bj = 0; bj < 2; ++bj) { const f32x4 a0 = acc[ai][bj][m][0], a1 = acc[ai][bj][m][1];
                    const u32x4 gw = __builtin_nontemporal_load((const u32x4*)(GL + off + bj * 128));
                    u32x4 w; w.x = cvt_pk_bf16(a0[0] * bf_lo(gw.x), a0[1] * bf_hi(gw.x)); w.y = cvt_pk_bf16(a0[2] * bf_lo(gw.y), a0[3] * bf_hi(gw.y));
                    w.z = cvt_pk_bf16(a1[0] * bf_lo(gw.z), a1[1] * bf_hi(gw.z)); w.w = cvt_pk_bf16(a1[2] * bf_lo(gw.w), a1[3] * bf_hi(gw.w));
                    *(u32x4*)(MIX + off + bj * 128) = w; } }
    }
};
struct EpiRes {
    static constexpr bool PERM = false;
    const float* x; const float* g2; float* out; bf16_t* HG; float* rowss; int noatom;
    __device__ __forceinline__ void init(f32x4 (&acc)[2][2][4][2], const Unit& u, int wr, int wc, int fr, int fq) const { acc_load_f32(acc, x, u, wr, wc, fr, fq); }
    __device__ __forceinline__ void operator()(const f32x4 (&acc)[2][2][4][2], const Unit& u, int wr, int wc, int fr, int fq) const {
        const int row0 = u.pm * 256 + wr * 64 + fr, col0 = u.pn * 256 + wc * 32 + 4 * fq;
        f32x4 gv[2][2];
#pragma unroll
        for (int bj = 0; bj < 2; ++bj)
#pragma unroll
            for (int n = 0; n < 2; ++n) gv[bj][n] = *(const f32x4*)(g2 + col0 + bj * 128 + n * 16);
#pragma unroll
        for (int ai = 0; ai < 2; ++ai)
#pragma unroll
            for (int m = 0; m < 4; ++m) { const int row = row0 + ai * 128 + m * 16; const size_t off = (size_t)row * DM + col0; float ss = 0.f;
#pragma unroll
                for (int bj = 0; bj < 2; ++bj)
#pragma unroll
                    for (int n = 0; n < 2; ++n) { const f32x4 h = acc[ai][bj][m][n];
                        __builtin_nontemporal_store(h, (f32x4*)(out + off + bj * 128 + n * 16));
                        ss += (h[0] * h[0] + h[1] * h[1]) + (h[2] * h[2] + h[3] * h[3]);
                        const f32x4 hg = h * gv[bj][n]; u32x2 w; w.x = cvt_pk_bf16(hg[0], hg[1]); w.y = cvt_pk_bf16(hg[2], hg[3]);
                        *(u32x2*)(HG + off + bj * 128 + n * 16) = w; }
                ss += __shfl_xor(ss, 16); ss += __shfl_xor(ss, 32);
                if (fq == 0 && !noatom) atomicAdd(rowss + row, ss); }
    }
};
struct EpiUp {
    static constexpr bool PERM = true;
    const float* rowss; bf16_t* U;
    EPI_ZERO_INIT
    __device__ __forceinline__ void operator()(const f32x4 (&acc)[2][2][4][2], const Unit& u, int wr, int wc, int fr, int fq) const {
        const int row0 = u.pm * 256 + wr * 64 + fr, col0 = u.pn * 256 + wc * 32 + 8 * fq;
#pragma unroll
        for (int ai = 0; ai < 2; ++ai)
#pragma unroll
            for (int m = 0; m < 4; ++m) { const int row = row0 + ai * 128 + m * 16; const float rs = __builtin_amdgcn_rsqf(rowss[row] * (1.0f / DM) + EPS);
                bf16_t* rowp = U + (size_t)row * FF + col0;
#pragma unroll
                for (int bj = 0; bj < 2; ++bj) { f32x4 v0 = acc[ai][bj][m][0] * rs, v1 = acc[ai][bj][m][1] * rs;
#pragma unroll
                    for (int e = 0; e < 4; ++e) { const float a = fmaxf(v0[e], 0.f), b = fmaxf(v1[e], 0.f); v0[e] = a * a; v1[e] = b * b; }
                    u32x4 w; w.x = cvt_pk_bf16(v0[0], v0[1]); w.y = cvt_pk_bf16(v0[2], v0[3]); w.z = cvt_pk_bf16(v1[0], v1[1]); w.w = cvt_pk_bf16(v1[2], v1[3]);
                    *(u32x4*)(rowp + bj * 128) = w; } }
    }
};
struct EpiDown {
    static constexpr bool PERM = false;
    float* out; int nostore;
    __device__ __forceinline__ void init(f32x4 (&acc)[2][2][4][2], const Unit& u, int wr, int wc, int fr, int fq) const { acc_load_f32(acc, out, u, wr, wc, fr, fq); }
    __device__ __forceinline__ void operator()(const f32x4 (&acc)[2][2][4][2], const Unit& u, int wr, int wc, int fr, int fq) const {
        const int row0 = u.pm * 256 + wr * 64 + fr, col0 = u.pn * 256 + wc * 32 + 4 * fq;
#pragma unroll
        for (int ai = 0; ai < 2; ++ai)
#pragma unroll
            for (int m = 0; m < 4; ++m) { const size_t off = (size_t)(row0 + ai * 128 + m * 16) * DM + col0;
#pragma unroll
                for (int bj = 0; bj < 2; ++bj)
#pragma unroll
                    for (int n = 0; n < 2; ++n) { float* p = out + off + bj * 128 + n * 16; if (!nostore) __builtin_nontemporal_store(acc[ai][bj][m][n], (f32x4*)p); } }
    }
};

struct Args {
    const float *x, *meta, *norm1_g, *w_in, *q_norm_g, *k_norm_g, *sinks, *w_o_attn, *conv_w, *conv_b, *lru_wa, *lru_ba, *lru_wi, *lru_bi, *lru_lambda, *w_o_lru, *w_out, *norm2_g, *w_up, *w_down;
    float* out; unsigned char* ws; int ph_lo, ph_hi, flags, pad;
};

__device__ __forceinline__ float wave_sum(float v) {
#pragma unroll
    for (int o = 1; o < 64; o <<= 1) v += __shfl_xor(v, o);
    return v;
}
__device__ __forceinline__ void transpose_load(f32x4 (&v)[16], const float* __restrict__ W, int N, int item, int lane) {
    const int nblk = N >> 6, kb = item / nblk, nb = item - kb * nblk, k0 = kb * 64, n0 = nb * 64;
    const int lr = lane >> 4, lc = (lane & 15) * 4;
    const unsigned off0 = (unsigned)((k0 + lr) * N + n0 + lc), rstep = (unsigned)(4 * N);
#pragma unroll
    for (int i = 0; i < 16; ++i) v[i] = __builtin_nontemporal_load((const f32x4*)(W + (off0 + (unsigned)i * rstep)));
}
template <bool NT = false> __device__ __forceinline__ void transpose_store(const f32x4 (&v)[16], int K, int N, bf16_t* __restrict__ WT, int row_off, LAS float* scr, int item, int lane) {
    const int nblk = N >> 6, kb = item / nblk, nb = item - kb * nblk, k0 = kb * 64, n0 = nb * 64;
    const int lr = lane >> 4, lc = (lane & 15) * 4;
#pragma unroll
    for (int i = 0; i < 16; ++i) { LAS float* s = scr + (4 * i + lr) * 65 + lc; s[0] = v[i][0]; s[1] = v[i][1]; s[2] = v[i][2]; s[3] = v[i][3]; }
    LDS_WAIT(); asm volatile("" ::: "memory");
    const int c = lane & 7, ns = lane >> 3;
    bf16_t* wp = WT + (size_t)(row_off + n0 + ns) * K + k0 + 8 * c; const size_t wstep = (size_t)8 * K;
#pragma unroll
    for (int j = 0; j < 8; ++j) { const LAS float* s = scr + (8 * c) * 65 + ns + 8 * j;
        u32x4 o; o.x = cvt_pk_bf16(s[0 * 65], s[1 * 65]); o.y = cvt_pk_bf16(s[2 * 65], s[3 * 65]); o.z = cvt_pk_bf16(s[4 * 65], s[5 * 65]); o.w = cvt_pk_bf16(s[6 * 65], s[7 * 65]);
        if (NT) __builtin_nontemporal_store(o, (u32x4*)wp); else *(u32x4*)wp = o;
        wp += wstep; asm volatile("" : "+v"(wp)); }
    LDS_WAIT(); asm volatile("" ::: "memory");
}
__device__ __forceinline__ void transpose_item(const float* __restrict__ W, int K, int N, bf16_t* __restrict__ WT, int row_off, LAS float* scr, int item, int lane) {
    f32x4 v[16]; transpose_load(v, W, N, item, lane); transpose_store(v, K, N, WT, row_off, scr, item, lane);
}
__device__ __forceinline__ void rms_row_to_bf16(const float* xrow, const float* g, bf16_t* orow, int lane) {
    const f32x4* xr = (const f32x4*)xrow + lane; const f32x4* gr = (const f32x4*)g + lane;
    f32x4 v[8], gv[8]; float s = 0.f;
#pragma unroll
    for (int j = 0; j < 8; ++j) { v[j] = xr[64 * j]; gv[j] = gr[64 * j]; }
#pragma unroll
    for (int j = 0; j < 8; ++j) s += (v[j][0] * v[j][0] + v[j][1] * v[j][1]) + (v[j][2] * v[j][2] + v[j][3] * v[j][3]);
    const float rs = 1.0f / sqrtf(wave_sum(s) * (1.0f / DM) + EPS);
    u32x2* o8 = (u32x2*)orow + lane;
#pragma unroll
    for (int j = 0; j < 8; ++j) { const f32x4 gg = gv[j]; u32x2 w; w.x = cvt_pk_bf16(v[j][0] * rs * gg[0], v[j][1] * rs * gg[1]); w.y = cvt_pk_bf16(v[j][2] * rs * gg[2], v[j][3] * rs * gg[3]); o8[64 * j] = w; }
}


#define XB_TMO      128
#define XB_XCNT(j)  (256  + 64 * (j))
#define XB_XSUB(j)  (1280 + 64 * (j))
#define XB_XGEN(j)  (2304 + 64 * (j))
#define XB_TOP      3328
#define XB_TOPGEN   3392
#define XCD_BAR_WORDS 3456
#define XB_SPIN_CAP (1u << 18)
__device__ __forceinline__ unsigned xb_ld(unsigned* p)              { return __hip_atomic_load(p, __ATOMIC_RELAXED, __HIP_MEMORY_SCOPE_AGENT); }
__device__ __forceinline__ unsigned xb_add(unsigned* p, unsigned v) { return __hip_atomic_fetch_add(p, v, __ATOMIC_RELAXED, __HIP_MEMORY_SCOPE_AGENT); }
__device__ __forceinline__ unsigned xb_xcc_id() { return (unsigned)__builtin_amdgcn_s_getreg((3 << 11) | 20) & 0xFu; }
#define XB_SPIN(cond, bar) do { unsigned _sp = 0; while (cond) { __builtin_amdgcn_s_sleep(1); \
    if ((++_sp & 255u) == 0u) { if (xb_ld(&(bar)[XB_TMO])) break; if (_sp > XB_SPIN_CAP) { atomicAdd(&(bar)[XB_TMO], 1u); break; } } } } while (0)
struct XcdBarrier { unsigned* bar; unsigned x; volatile LAS unsigned* st; };
__device__ __forceinline__ XcdBarrier xcd_barrier_post(unsigned* bar, volatile LAS unsigned* st) {
    XcdBarrier b; b.bar = bar; b.x = xb_xcc_id(); b.st = st;
    if (threadIdx.x == 0) (void)xb_add(&bar[XB_XCNT(b.x)], 1u);
    return b;
}
__device__ __forceinline__ void xcd_barrier_complete(unsigned* bar, unsigned x, unsigned& nloc, unsigned& nx) {
    const unsigned G = gridDim.x * gridDim.y * gridDim.z;
    unsigned sum, cnt, mine, sp = 0u;
    for (;;) {
        sum = 0u; cnt = 0u; mine = 0u;
#pragma unroll
        for (unsigned j = 0; j < 16; ++j) { const unsigned c = xb_ld(&bar[XB_XCNT(j)]); sum += c; cnt += (c > 0u) ? 1u : 0u; mine = (j == x) ? c : mine; }
        if (sum == G) break;
        __builtin_amdgcn_s_sleep(1);
        if ((++sp & 255u) == 0u) { if (xb_ld(&bar[XB_TMO])) break; if (sp > XB_SPIN_CAP) { atomicAdd(&bar[XB_TMO], 1u); break; } }
    }
    nloc = mine > 0u ? mine : 1u; nx = cnt > 0u ? cnt : 1u;
}
__device__ __forceinline__ void xcd_barrier(const XcdBarrier& b) {
    asm volatile("s_waitcnt vmcnt(0)" ::: "memory");
    __syncthreads();
    if (threadIdx.x == 0) {
        unsigned* bar = b.bar;
        __builtin_amdgcn_s_waitcnt(0);
        unsigned nloc = b.st[0], nx = b.st[1];
        if (nloc == 0u) { xcd_barrier_complete(bar, b.x, nloc, nx); b.st[0] = nloc; b.st[1] = nx; }
        const unsigned old = xb_add(&bar[XB_XSUB(b.x)], 1u);
        const unsigned gen = old / nloc;
        if (old + 1u == (gen + 1u) * nloc) {
            __builtin_amdgcn_fence(__ATOMIC_RELEASE, "agent");
            asm volatile("s_waitcnt vmcnt(0)" ::: "memory");
            const unsigned og = xb_add(&bar[XB_TOP], 1u);
            const unsigned tg = og / nx;
            if (og + 1u == (tg + 1u) * nx) xb_add(&bar[XB_TOPGEN], 1u);
            else XB_SPIN(xb_ld(&bar[XB_TOPGEN]) == tg, bar);
            __builtin_amdgcn_fence(__ATOMIC_ACQUIRE, "agent");
            xb_add(&bar[XB_XGEN(b.x)], 1u);
            asm volatile("s_waitcnt vmcnt(0)" ::: "memory");
        } else {
            XB_SPIN(xb_ld(&bar[XB_XGEN(b.x)]) == gen, bar);
            __builtin_amdgcn_fence(__ATOMIC_ACQUIRE, "agent");
            asm volatile("s_waitcnt vmcnt(0)" ::: "memory");
        }
    }
    __syncthreads();
}

__global__ void __launch_bounds__(NTHREADS, 2) fwd_kernel(Args a) {
    extern __shared__ __attribute__((aligned(16))) unsigned char lds_raw[];
    LAS unsigned char* lds = (LAS unsigned char*)lds_raw;
    const int tid = threadIdx.x, lane = tid & 63, wave = __builtin_amdgcn_readfirstlane(tid >> 6);
    const int G = gridDim.x, bid = blockIdx.x;
    unsigned char* ws = a.ws;
    float* rowss = (float*)(ws + WS_CTL);
    bf16_t* Wt_in = (bf16_t*)(ws + WS_WTIN); bf16_t* XN = (bf16_t*)(ws + WS_XN);
    bf16_t* Wt_up = (bf16_t*)(ws + WS_WTUP); bf16_t* Wt_dn = (bf16_t*)(ws + WS_WTDN);
    bf16_t* Wt_oa = (bf16_t*)(ws + WS_WOA); bf16_t* Wt_ol = (bf16_t*)(ws + WS_WOL); bf16_t* Wt_out = (bf16_t*)(ws + WS_WOUT);
    bf16_t* Wt_a = (bf16_t*)(ws + WS_WA); bf16_t* Wt_i = (bf16_t*)(ws + WS_WI);
    bf16_t* Qb = (bf16_t*)(ws + WS_Q); bf16_t* Kb = (bf16_t*)(ws + WS_K); bf16_t* Vb = (bf16_t*)(ws + WS_V);
    bf16_t* LX = (bf16_t*)(ws + WS_LX); bf16_t* LG = (bf16_t*)(ws + WS_LG); bf16_t* GA = (bf16_t*)(ws + WS_GA); bf16_t* GL = (bf16_t*)(ws + WS_GL);
    bf16_t* MIX = LX; bf16_t* HG = Qb; bf16_t* U = (bf16_t*)(ws + WS_U); bf16_t* Ob = (bf16_t*)(ws + WS_O); bf16_t* REC = (bf16_t*)(ws + WS_REC);
    const int lo = a.ph_lo, hi = a.ph_hi;
#define IN(k) (lo <= (k) && (k) < hi)
    volatile LAS unsigned* bst = (volatile LAS unsigned*)(lds + LDS_BYTES - 16);
    if (tid < 4) bst[tid] = 0u;
    __syncthreads();
    const XcdBarrier xbar = xcd_barrier_post((unsigned*)(ws + WS_BAR) + (a.flags >> 8) * XCD_BAR_WORDS, bst);
#define SEAM(k) do { if (IN(k) && IN((k) + 1)) { xcd_barrier(xbar); } } while (0)
    if (a.ph_lo < 0) cg::this_grid().sync();

    if (IN(0)) {
        LAS float* scr = (LAS float*)(lds + wave * 16640);
        const int gw = bid * NWAVES + wave, NGW = G * NWAVES;
        constexpr int I_IN = 32 * 168, NITEMS = I_IN;
#define P0_DESC(IT, W_, K_, N_, WT_, RO_, LI_) do { int r_ = (IT) < NITEMS ? (IT) : NITEMS - 1;   \
            { const int n0_ = (r_ % (INW / 64)) * 64; int ro_ = 0;     \
                if (n0_ >= 6656) { const int c_ = n0_ - 6656, isgl_ = c_ >> 11, cc_ = c_ & 2047; ro_ = 6656 + (cc_ >> 7) * 256 + isgl_ * 128 + (cc_ & 127) - n0_; } \
                W_ = a.w_in; K_ = DM; N_ = INW; WT_ = Wt_in; RO_ = ro_; LI_ = r_; } } while (0)
        {
            f32x4 va[16], vb[16], vc[16];
            const float* wA; bf16_t* tA; int kA, nA, rA, lA; const float* wB; bf16_t* tB; int kB, nB, rB, lB; const float* wC; bf16_t* tC; int kC, nC, rC, lC;
            P0_DESC(gw, wA, kA, nA, tA, rA, lA); transpose_load(va, wA, nA, lA, lane);
            P0_DESC(gw + NGW, wB, kB, nB, tB, rB, lB); transpose_load(vb, wB, nB, lB, lane);
#pragma unroll 1
            for (int it = gw; it < NITEMS; it += 3 * NGW) {
                P0_DESC(it + 2 * NGW, wC, kC, nC, tC, rC, lC); transpose_load(vc, wC, nC, lC, lane);
                transpose_store(va, kA, nA, tA, rA, scr, lA, lane);
                P0_DESC(it + 3 * NGW, wA, kA, nA, tA, rA, lA); transpose_load(va, wA, nA, lA, lane);
                transpose_store(vb, kB, nB, tB, rB, scr, lB, lane);
                P0_DESC(it + 4 * NGW, wB, kB, nB, tB, rB, lB); transpose_load(vb, wB, nB, lB, lane);
                transpose_store(vc, kC, nC, tC, rC, scr, lC, lane);
            }
        }
#undef P0_DESC
        {
            const f32x4* gr = (const f32x4*)a.norm1_g + lane; f32x4 gv[8];
#pragma unroll
            for (int j = 0; j < 8; ++j) gv[j] = gr[64 * j];
#define P0_ROWSRC(M) ((M) < MR ? a.x + (size_t)(M) * DM : a.meta + (size_t)(((M) < MR + NMETA ? (M) : MR + NMETA - 1) - MR) * DM)
            f32x4 vn[8];
            { const f32x4* xr = (const f32x4*)P0_ROWSRC(gw) + lane;
#pragma unroll
              for (int j = 0; j < 8; ++j) vn[j] = __builtin_nontemporal_load(xr + 64 * j); }
#pragma unroll 1
            for (int m = gw; m < MR + NMETA; m += NGW) {
                f32x4 v[8];
#pragma unroll
                for (int j = 0; j < 8; ++j) v[j] = vn[j];
                { const f32x4* xr = (const f32x4*)P0_ROWSRC(m + NGW) + lane;
#pragma unroll
                  for (int j = 0; j < 8; ++j) vn[j] = __builtin_nontemporal_load(xr + 64 * j); }
                float ssq = 0.f;
#pragma unroll
                for (int j = 0; j < 8; ++j) ssq += (v[j][0] * v[j][0] + v[j][1] * v[j][1]) + (v[j][2] * v[j][2] + v[j][3] * v[j][3]);
                const float rs = 1.0f / sqrtf(wave_sum(ssq) * (1.0f / DM) + EPS);
                u32x2* o8 = (u32x2*)(XN + (size_t)m * DM) + lane;
#pragma unroll
                for (int j = 0; j < 8; ++j) { u32x2 w; w.x = cvt_pk_bf16(v[j][0] * rs * gv[j][0], v[j][1] * rs * gv[j][1]); w.y = cvt_pk_bf16(v[j][2] * rs * gv[j][2], v[j][3] * rs * gv[j][3]); o8[64 * j] = w; }
            }
#undef P0_ROWSRC
            for (int m = MR + NMETA + gw; m < MPAD; m += NGW) { u32x4* o = (u32x4*)(XN + (size_t)m * DM) + lane;
#pragma unroll
                for (int j = 0; j < 4; ++j) o[64 * j] = (u32x4){0u, 0u, 0u, 0u}; }
        }
        for (int i = bid * NTHREADS + tid; i < MR; i += G * NTHREADS) rowss[i] = 0.f;
    }
    SEAM(0);

    if (IN(1)) {
        const int NT_CU = (G >= 128) ? (G * 30) / 256 : 0, NG = G - NT_CU;
        if (bid < NG) {
            SchedIn S{(const char*)XN, (const char*)Wt_in, NG, bid};
            EpiIn E{Qb, Kb, Vb, LX, LG, GA, GL};
            pg8::gemm_phase<EpiIn, SchedIn>(lds, DM, S, E);
        }
        if (bid >= NG || NT_CU == 0) {
            LAS float* scr = (LAS float*)(lds + wave * 16640);
            const int gw = (NT_CU ? bid - NG : bid) * NWAVES + wave, NGW = (NT_CU ? NT_CU : G) * NWAVES;
            constexpr int I_UP = 32 * 128, I_DN = 128 * 32, I_SQ1 = 32 * 32, I_LRU1 = 16 * 16, NIT = I_UP + I_DN + 3 * I_SQ1 + I_LRU1;
#define P1_DESC(IT, W_, K_, N_, WT_, LI_) do { const int r_ = (IT) < NIT ? (IT) : NIT - 1;   \
                if (r_ < I_UP) { W_ = a.w_up; K_ = DM; N_ = FF; WT_ = Wt_up; LI_ = r_; } \
                else if (r_ < I_UP + I_DN) { W_ = a.w_down; K_ = FF; N_ = DM; WT_ = Wt_dn; LI_ = r_ - I_UP; } \
                else if (r_ < I_UP + I_DN + I_SQ1) { W_ = a.w_o_attn; K_ = DM; N_ = DM; WT_ = Wt_oa; LI_ = r_ - I_UP - I_DN; } \
                else if (r_ < I_UP + I_DN + 2 * I_SQ1) { W_ = a.w_o_lru; K_ = DM; N_ = DM; WT_ = Wt_ol; LI_ = r_ - I_UP - I_DN - I_SQ1; } \
                else if (r_ < I_UP + I_DN + 3 * I_SQ1) { W_ = a.w_out; K_ = DM; N_ = DM; WT_ = Wt_out; LI_ = r_ - I_UP - I_DN - 2 * I_SQ1; } \
                else { const int q_ = r_ - I_UP - I_DN - 3 * I_SQ1, mat_ = q_ >> 4, which_ = mat_ >> 3, n_ = mat_ & 7;     \
                    W_ = (which_ ? a.lru_wi : a.lru_wa) + (size_t)n_ * 65536; K_ = 256; N_ = 256; WT_ = (which_ ? Wt_i : Wt_a) + (size_t)n_ * 65536; LI_ = q_ & 15; } } while (0)
            f32x4 va[16], vb[16];
            const float* wA; bf16_t* tA; int kA, nA, lA; const float* wB; bf16_t* tB; int kB, nB, lB;
            P1_DESC(gw, wA, kA, nA, tA, lA); transpose_load(va, wA, nA, lA, lane);
#pragma unroll 1
            for (int it = gw; it < NIT; it += 2 * NGW) {
                P1_DESC(it + NGW, wB, kB, nB, tB, lB); transpose_load(vb, wB, nB, lB, lane);
                transpose_store<true>(va, kA, nA, tA, 0, scr, lA, lane);
                P1_DESC(it + 2 * NGW, wA, kA, nA, tA, lA); transpose_load(va, wA, nA, lA, lane);
                transpose_store<true>(vb, kB, nB, tB, 0, scr, lB, lane);
            }
#undef P1_DESC
        }
    }
    SEAM(1);

    {
        if (IN(3)) {
            constexpr int KS_STRIDE = 144  , VT_STRIDE = 552  , VT_OFF = 39424;
            const int fr = lane & 15, fq = lane >> 4;
            for (int ub = bid; ub < 256; ub += G) {
                const int vu = (G == 256) ? (ub & 7) * 32 + (ub >> 3) : ub;
                const int b = vu >> 6, g = (vu >> 4) & 3, qb = vu & 15;
                {
                    const int ch = tid & 7;
                    float gk[8];
#pragma unroll
                    for (int e = 0; e < 8; ++e) gk[e] = a.k_norm_g[ch * 8 + e];
                    u32x4 kws[5], vws[5];
#pragma unroll
                    for (int it = 0; it < 5; ++it) {
                        const int key = (it * NTHREADS + tid) >> 3;
                        bool ld = key < 272; int row = 0;
                        if (key < 16) row = MR + key;
                        else { const int ik = key - 16; row = b * SEQ + qb * 128 - 128 + ik; if (qb == 0 && ik < 128) ld = false; }
                        kws[it] = (u32x4){0u, 0u, 0u, 0u}; vws[it] = (u32x4){0u, 0u, 0u, 0u};
                        if (ld) { kws[it] = *(const u32x4*)(Kb + (size_t)row * KVW + g * 64 + ch * 8); vws[it] = *(const u32x4*)(Vb + (size_t)row * KVW + g * 64 + ch * 8); }
                    }
#pragma unroll
                    for (int it = 0; it < 5; ++it) {
                        const int key = (it * NTHREADS + tid) >> 3;
                        const u32x4 kw = kws[it], vw = vws[it];
                        float kf[8] = {bf_lo(kw.x), bf_hi(kw.x), bf_lo(kw.y), bf_hi(kw.y), bf_lo(kw.z), bf_hi(kw.z), bf_lo(kw.w), bf_hi(kw.w)};
                        float ss = 0.f;
#pragma unroll
                        for (int e = 0; e < 8; ++e) ss += kf[e] * kf[e];
                        ss += __shfl_xor(ss, 1); ss += __shfl_xor(ss, 2); ss += __shfl_xor(ss, 4);
                        const float sc = 1.0f / sqrtf(ss * (1.0f / 64.0f) + EPS);
                        if (key < 272) {
                            u32x4 o; o.x = cvt_pk_bf16(kf[0] * sc * gk[0], kf[1] * sc * gk[1]); o.y = cvt_pk_bf16(kf[2] * sc * gk[2], kf[3] * sc * gk[3]);
                            o.z = cvt_pk_bf16(kf[4] * sc * gk[4], kf[5] * sc * gk[5]); o.w = cvt_pk_bf16(kf[6] * sc * gk[6], kf[7] * sc * gk[7]);
                            *(LAS u32x4*)(lds + key * KS_STRIDE + ch * 16) = o;
                            LAS bf16_t* vt = (LAS bf16_t*)(lds + VT_OFF + (ch * 8) * VT_STRIDE + key * 2);
                            vt[0 * (VT_STRIDE / 2)] = (bf16_t)(vw.x & 0xffffu); vt[1 * (VT_STRIDE / 2)] = (bf16_t)(vw.x >> 16);
                            vt[2 * (VT_STRIDE / 2)] = (bf16_t)(vw.y & 0xffffu); vt[3 * (VT_STRIDE / 2)] = (bf16_t)(vw.y >> 16);
                            vt[4 * (VT_STRIDE / 2)] = (bf16_t)(vw.z & 0xffffu); vt[5 * (VT_STRIDE / 2)] = (bf16_t)(vw.z >> 16);
                            vt[6 * (VT_STRIDE / 2)] = (bf16_t)(vw.w & 0xffffu); vt[7 * (VT_STRIDE / 2)] = (bf16_t)(vw.w >> 16);
                        }
                    }
                }
                __syncthreads();
                const int h = g * 8 + wave;
                const float sinkl = a.sinks[h] * LOG2E;
                float gq[16];
#pragma unroll
                for (int e = 0; e < 8; ++e) { gq[e] = a.q_norm_g[8 * fq + e]; gq[8 + e] = a.q_norm_g[32 + 8 * fq + e]; }
                u32x4 q0n, q1n;
                { const bf16_t* qp0 = Qb + (size_t)(b * SEQ + qb * 128 + fr) * DM + h * 64; q0n = *(const u32x4*)(qp0 + 8 * fq); q1n = *(const u32x4*)(qp0 + 32 + 8 * fq); }
#pragma unroll 1
                for (int mt = 0; mt < 8; ++mt) {
                    const size_t qrow = (size_t)(b * SEQ + qb * 128 + mt * 16 + fr);
                    const u32x4 q0 = q0n, q1 = q1n;
                    { const bf16_t* qpn = Qb + (qrow + (mt < 7 ? 16 : 0)) * DM + h * 64; q0n = *(const u32x4*)(qpn + 8 * fq); q1n = *(const u32x4*)(qpn + 32 + 8 * fq); }
                    float qf[16] = {bf_lo(q0.x), bf_hi(q0.x), bf_lo(q0.y), bf_hi(q0.y), bf_lo(q0.z), bf_hi(q0.z), bf_lo(q0.w), bf_hi(q0.w),
                                    bf_lo(q1.x), bf_hi(q1.x), bf_lo(q1.y), bf_hi(q1.y), bf_lo(q1.z), bf_hi(q1.z), bf_lo(q1.w), bf_hi(q1.w)};
                    float ss = 0.f;
#pragma unroll
                    for (int e = 0; e < 16; ++e) ss += qf[e] * qf[e];
                    ss += __shfl_xor(ss, 16); ss += __shfl_xor(ss, 32);
                    const float sc = (0.125f * LOG2E) / sqrtf(ss * (1.0f / 64.0f) + EPS);
                    u32x4 qa, qc;
                    qa.x = cvt_pk_bf16(qf[0] * sc * gq[0], qf[1] * sc * gq[1]); qa.y = cvt_pk_bf16(qf[2] * sc * gq[2], qf[3] * sc * gq[3]);
                    qa.z = cvt_pk_bf16(qf[4] * sc * gq[4], qf[5] * sc * gq[5]); qa.w = cvt_pk_bf16(qf[6] * sc * gq[6], qf[7] * sc * gq[7]);
                    qc.x = cvt_pk_bf16(qf[8] * sc * gq[8], qf[9] * sc * gq[9]); qc.y = cvt_pk_bf16(qf[10] * sc * gq[10], qf[11] * sc * gq[11]);
                    qc.z = cvt_pk_bf16(qf[12] * sc * gq[12], qf[13] * sc * gq[13]); qc.w = cvt_pk_bf16(qf[14] * sc * gq[14], qf[15] * sc * gq[15]);
                    const bf16x8 qfr0 = __builtin_bit_cast(bf16x8, qa), qfr1 = __builtin_bit_cast(bf16x8, qc);
                    f32x4 st[10];
#pragma unroll
                    for (int j = 0; j < 10; ++j) {
                        const int kbase = (j == 0) ? 0 : 16 + 16 * (mt + j - 1);
                        const LAS unsigned char* kp = lds + (kbase + fr) * KS_STRIDE + fq * 16;
                        const bf16x8 k0 = *(const LAS bf16x8*)(kp), k1 = *(const LAS bf16x8*)(kp + 64);
                        f32x4 s = (f32x4){0.f, 0.f, 0.f, 0.f};
                        s = __builtin_amdgcn_mfma_f32_16x16x32_bf16(k0, qfr0, s, 0, 0, 0);
                        s = __builtin_amdgcn_mfma_f32_16x16x32_bf16(k1, qfr1, s, 0, 0, 0);
                        st[j] = s;
                    }
#pragma unroll
                    for (int r = 0; r < 4; ++r) { const int d1 = 4 * fq + r - fr; st[1][r] = (d1 >= 1) ? st[1][r] : -1e30f; st[9][r] = (d1 <= 0) ? st[9][r] : -1e30f; }
                    if (qb == 0) {
#pragma unroll
                        for (int j = 1; j < 10; ++j)
#pragma unroll
                            for (int r = 0; r < 4; ++r) st[j][r] = ((16 * (mt + j - 1) + 4 * fq + r) < 128) ? -1e30f : st[j][r];
                    }
                    float mx = sinkl;
#pragma unroll
                    for (int j = 0; j < 10; ++j) mx = fmaxf(fmaxf(mx, fmaxf(st[j][0], st[j][1])), fmaxf(st[j][2], st[j][3]));
                    mx = fmaxf(mx, __shfl_xor(mx, 16)); mx = fmaxf(mx, __shfl_xor(mx, 32));
                    float den = 0.f;
#pragma unroll
                    for (int j = 0; j < 10; ++j)
#pragma unroll
                        for (int r = 0; r < 4; ++r) { const float p = __builtin_amdgcn_exp2f(st[j][r] - mx); st[j][r] = p; den += p; }
                    den += __shfl_xor(den, 16); den += __shfl_xor(den, 32);
                    den += __builtin_amdgcn_exp2f(sinkl - mx);
                    const float rden = 1.0f / den;
                    f32x4 o[4];
#pragma unroll
                    for (int dt = 0; dt < 4; ++dt) o[dt] = (f32x4){0.f, 0.f, 0.f, 0.f};
#pragma unroll
                    for (int kp = 0; kp < 5; ++kp) {
                        u32x4 pw; pw.x = cvt_pk_bf16(st[2 * kp][0], st[2 * kp][1]); pw.y = cvt_pk_bf16(st[2 * kp][2], st[2 * kp][3]);
                        pw.z = cvt_pk_bf16(st[2 * kp + 1][0], st[2 * kp + 1][1]); pw.w = cvt_pk_bf16(st[2 * kp + 1][2], st[2 * kp + 1][3]);
                        const bf16x8 pfr = __builtin_bit_cast(bf16x8, pw);
                        const int kb0 = (kp == 0) ? 0 : 16 + 16 * (mt + 2 * kp - 1), kb1 = 16 + 16 * (mt + 2 * kp);
#pragma unroll
                        for (int dt = 0; dt < 4; ++dt) {
                            const LAS unsigned char* vp = lds + VT_OFF + (16 * dt + fr) * VT_STRIDE + 8 * fq;
                            const u32x2 va = *(const LAS u32x2*)(vp + 2 * kb0), vb = *(const LAS u32x2*)(vp + 2 * kb1);
                            const u32x4 vv = (u32x4){va.x, va.y, vb.x, vb.y};
                            o[dt] = __builtin_amdgcn_mfma_f32_16x16x32_bf16(__builtin_bit_cast(bf16x8, vv), pfr, o[dt], 0, 0, 0);
                        }
                    }
#pragma unroll
                    for (int dt = 0; dt < 4; ++dt) { u32x2 w; w.x = cvt_pk_bf16(o[dt][0] * rden, o[dt][1] * rden); w.y = cvt_pk_bf16(o[dt][2] * rden, o[dt][3] * rden);
                        *(u32x2*)(Ob + qrow * DM + h * 64 + 16 * dt + 4 * fq) = w; }
                }
                __syncthreads();
            }
        }
        if (IN(4)) {
            constexpr int AT_STRIDE = 528  , WL_OFF = 67584, AB_OFF = 101376, BB_OFF = 117888, SEG_OFF = 134400, CARRY_OFF = 138496, GC_OFF = 138752, CW_OFF = 139136, ABS = 129  ;
            static_assert(CW_OFF + 5120 <= LDS_BYTES, "LRU LDS map");
            const int fr = lane & 15, fq = lane >> 4;
            for (int itb = bid; itb < 256; itb += G) {
                const int item = (G == 256) ? (itb & 7) * 32 + (itb >> 3) : itb;
                const int b = item >> 6, n = (item >> 3) & 7, d0 = (item & 7) * 32, cb = n * 256 + d0;
                const int cg8 = tid & 31, seg = tid >> 5; const int cch = n * 256 + cg8 * 8;
                {
                    u32x4 wtmp[4]; float ctmp[3], gtmp[3];
#pragma unroll
                    for (int k = 0; k < 4; ++k) { const int i = tid + k * NTHREADS, gate = i >> 10, dd = (i >> 5) & 31, kc = i & 31;
                        wtmp[k] = *(const u32x4*)((gate ? Wt_i : Wt_a) + (size_t)(n * 256 + d0 + dd) * 256 + kc * 8); }
#pragma unroll
                    for (int k = 0; k < 3; ++k) { const int i = tid + k * NTHREADS, ic = i < 1280 ? i : 1279, tp = ic >> 8, c = ic & 255;
                        const float* src = (tp < 4) ? a.conv_w + tp * DM + n * 256 + c : a.conv_b + n * 256 + c; ctmp[k] = *src; }
                    { const int ch = cb + (tid & 31); gtmp[0] = a.lru_lambda[ch]; gtmp[1] = a.lru_ba[ch]; gtmp[2] = a.lru_bi[ch]; }
#pragma unroll
                    for (int k = 0; k < 4; ++k) { const int i = tid + k * NTHREADS, gate = i >> 10, dd = (i >> 5) & 31, kc = i & 31;
                        *(LAS u32x4*)(lds + WL_OFF + (gate * 32 + dd) * AT_STRIDE + kc * 16) = wtmp[k]; }
#pragma unroll
                    for (int k = 0; k < 3; ++k) { const int i = tid + k * NTHREADS; if (i < 1280) ((LAS float*)(lds + CW_OFF))[i] = ctmp[k]; }
                    if (tid < 32) { const float lam = gtmp[0];
                        ((LAS float*)(lds + GC_OFF))[tid] = (lam > 15.f) ? __expf(-lam) : log1pf(__expf(-lam)); ((LAS float*)(lds + GC_OFF))[32 + tid] = gtmp[1]; ((LAS float*)(lds + GC_OFF))[64 + tid] = gtmp[2]; }
                    if (tid < 64) ((LAS float*)(lds + CARRY_OFF))[tid] = 0.f;
                }
                __syncthreads();
                const u32x4 zero4 = (u32x4){0u, 0u, 0u, 0u};
                const int sch0 = tid & 31, seg0 = seg, fr0 = fr, fq0 = fq, cg80 = cg8;
#define LRU_LOAD_ROWS(TI) do { const bf16_t* base_ = LX + ((long)(b * 2064 + ((TI) == 0 ? 0 : 16 + ((TI) - 1) * 128) + seg * 8 - 3)) * DM + cch; \
                    _Pragma("unroll") for (int q_ = 0; q_ < 11; ++q_) { const bool ok_ = !((TI) == 0 && seg == 0 && q_ < 3); lxr[q_] = zero4; if (ok_) lxr[q_] = *(const u32x4*)(base_ + (long)q_ * DM); } } while (0)
                u32x4 lxr[11];
                LRU_LOAD_ROWS(0);
#pragma unroll 1
                for (int ti = 0; ti < 17; ++ti) {
                    int seg = seg0, sch = sch0, fr = fr0, fq = fq0, cg8 = cg80;
                    asm volatile("" : "+v"(seg), "+v"(sch), "+v"(fr), "+v"(fq), "+v"(cg8));
                    {
                        f32x2 win[3][4], cw[4][4], cbias[4];
#pragma unroll
                        for (int p = 0; p < 4; ++p) { win[0][p] = (f32x2){0.f, 0.f}; win[1][p] = (f32x2){0.f, 0.f}; win[2][p] = (f32x2){0.f, 0.f}; }
#pragma unroll
                        for (int tp = 0; tp < 5; ++tp) { const f32x4 c0 = *(const LAS f32x4*)(lds + CW_OFF + (tp * 256 + cg8 * 8) * 4), c1 = *(const LAS f32x4*)(lds + CW_OFF + (tp * 256 + cg8 * 8 + 4) * 4);
                            if (tp < 4) { cw[tp & 3][0] = (f32x2){c0[0], c0[1]}; cw[tp & 3][1] = (f32x2){c0[2], c0[3]}; cw[tp & 3][2] = (f32x2){c1[0], c1[1]}; cw[tp & 3][3] = (f32x2){c1[2], c1[3]}; }
                            else { cbias[0] = (f32x2){c0[0], c0[1]}; cbias[1] = (f32x2){c0[2], c0[3]}; cbias[2] = (f32x2){c1[0], c1[1]}; cbias[3] = (f32x2){c1[2], c1[3]}; } }
#pragma unroll
                        for (int q = 0; q < 11; ++q) {
                            const u32x4 w = lxr[q];
                            const f32x2 cur[4] = {(f32x2){bf_lo(w.x), bf_hi(w.x)}, (f32x2){bf_lo(w.y), bf_hi(w.y)}, (f32x2){bf_lo(w.z), bf_hi(w.z)}, (f32x2){bf_lo(w.w), bf_hi(w.w)}};
                            if (q >= 3) {
                                f32x2 y[4];
#pragma unroll
                                for (int p = 0; p < 4; ++p) y[p] = __builtin_elementwise_fma(cur[p], cw[3][p], __builtin_elementwise_fma(win[2][p], cw[2][p], __builtin_elementwise_fma(win[1][p], cw[1][p], __builtin_elementwise_fma(win[0][p], cw[0][p], cbias[p]))));
                                u32x4 o; o.x = cvt_pk_bf16(y[0][0], y[0][1]); o.y = cvt_pk_bf16(y[1][0], y[1][1]); o.z = cvt_pk_bf16(y[2][0], y[2][1]); o.w = cvt_pk_bf16(y[3][0], y[3][1]);
                                *(LAS u32x4*)(lds + (seg * 8 + q - 3) * AT_STRIDE + cg8 * 16) = o;
                            }
#pragma unroll
                            for (int p = 0; p < 4; ++p) { win[0][p] = win[1][p]; win[1][p] = win[2][p]; win[2][p] = cur[p]; }
                        }
                    }
                    const size_t row0 = (size_t)(b * SEQ + (ti > 0 ? ti - 1 : 0) * 128 + 8 * seg);
                    unsigned lgv[8];
                    { const bf16_t* lgp = LG + row0 * DM + cb + sch;
#pragma unroll
                      for (int j = 0; j < 8; ++j) lgv[j] = lgp[(size_t)j * DM]; }
                    { const int tn = ti < 16 ? ti + 1 : 16; LRU_LOAD_ROWS(tn); }
                    WG_BAR();
                    {
                        f32x4 acc[2][2];
#pragma unroll
                        for (int gt = 0; gt < 2; ++gt)
#pragma unroll
                            for (int nt = 0; nt < 2; ++nt) acc[gt][nt] = (f32x4){0.f, 0.f, 0.f, 0.f};
#pragma unroll
                        for (int ks = 0; ks < 8; ++ks) {
                            const bf16x8 af = *(const LAS bf16x8*)(lds + (16 * wave + fr) * AT_STRIDE + ks * 64 + fq * 16);
#pragma unroll
                            for (int gt = 0; gt < 2; ++gt)
#pragma unroll
                                for (int nt = 0; nt < 2; ++nt) {
                                    const bf16x8 wf = *(const LAS bf16x8*)(lds + WL_OFF + (gt * 32 + 16 * nt + fr) * AT_STRIDE + ks * 64 + fq * 16);
                                    acc[gt][nt] = __builtin_amdgcn_mfma_f32_16x16x32_bf16(wf, af, acc[gt][nt], 0, 0, 0);
                                }
                        }
                        const int tk = 16 * wave + fr;
#pragma unroll
                        for (int nt = 0; nt < 2; ++nt)
#pragma unroll
                            for (int r = 0; r < 4; ++r) {
                                const int ch = 16 * nt + 4 * fq + r;
                                const float splv = ((LAS float*)(lds + GC_OFF))[ch], bavv = ((LAS float*)(lds + GC_OFF))[32 + ch], bivv = ((LAS float*)(lds + GC_OFF))[64 + ch];
                                const float rg = fast_sigmoid(acc[0][nt][r] + bavv), ig = fast_sigmoid(acc[1][nt][r] + bivv);
                                const float la = -8.0f * rg * splv;
                                const float av = __builtin_amdgcn_exp2f(la * LOG2E);
                                const float t2 = 2.0f * la;
                                const float m2s = -t2 * (1.0f + t2 * (0.5f + t2 * (0.16666667f + t2 * (0.041666668f + t2 * (0.0083333338f + t2 * 0.0013888889f)))));
                                const float m2 = (t2 > -0.25f) ? m2s : (1.0f - av * av);
                                float mult = __builtin_amdgcn_sqrtf(fmaxf(m2, 0.f));
                                if (ti == 0 && tk == 0) mult = 1.0f;
                                const float xv = bf2f(*(const LAS bf16_t*)(lds + tk * AT_STRIDE + (d0 + ch) * 2));
                                ((LAS float*)(lds + AB_OFF))[ch * ABS + tk] = av;
                                ((LAS float*)(lds + BB_OFF))[ch * ABS + tk] = mult * ig * xv;
                            }
                    }
                    WG_BAR();
                    {
                        float A = 1.f, H = 0.f;
#pragma unroll
                        for (int j = 0; j < 8; ++j) { const float av = ((LAS float*)(lds + AB_OFF))[sch * ABS + 8 * seg + j], bv = ((LAS float*)(lds + BB_OFF))[sch * ABS + 8 * seg + j]; H = av * H + bv; A *= av; }
                        ((LAS f32x2*)(lds + SEG_OFF))[seg * 32 + sch] = (f32x2){A, H};
                    }
                    WG_BAR();
                    {
#pragma unroll
                        for (int j = 0; j < 8; ++j) asm volatile("" : "+v"(lgv[j]));
                        float hst = ((LAS float*)(lds + CARRY_OFF))[(ti & 1) * 32 + sch];
                        f32x2 shs[15];
#pragma unroll
                        for (int s2 = 0; s2 < 15; ++s2) shs[s2] = ((LAS f32x2*)(lds + SEG_OFF))[s2 * 32 + sch];
#pragma unroll
                        for (int s2 = 0; s2 < 15; ++s2) hst = (s2 < seg) ? shs[s2].x * hst + shs[s2].y : hst;
#pragma unroll
                        for (int j = 0; j < 8; ++j) { const float av = ((LAS float*)(lds + AB_OFF))[sch * ABS + 8 * seg + j], bv = ((LAS float*)(lds + BB_OFF))[sch * ABS + 8 * seg + j]; hst = av * hst + bv;
                            if (ti > 0) REC[(row0 + j) * DM + cb + sch] = (bf16_t)(cvt_pk_bf16(__uint_as_float(lgv[j] << 16) * hst, 0.f) & 0xffffu); }
                        const int lastseg = (ti == 0) ? 1 : 15;
                        if (seg == lastseg) ((LAS float*)(lds + CARRY_OFF))[((ti + 1) & 1) * 32 + sch] = hst;
                    }
                }
#undef LRU_LOAD_ROWS
                __syncthreads();
            }
        }
    }
    SEAM(4);

    if (IN(5)) {
        SchedMix S{(const char*)Ob, (const char*)REC, (const char*)Wt_oa, (const char*)Wt_ol, G, bid};
        EpiMix E{GA, GL, MIX};
        pg8::gemm_phase<EpiMix, SchedMix, true>(lds, 2 * DM, S, E);
    }
    SEAM(5);

    if (IN(6)) {
        SchedPlain S{(const char*)MIX, (const char*)Wt_out, 32, 8, DM, G, bid};
        EpiRes E{a.x, a.norm2_g, a.out, HG, rowss, a.flags & 1};
        pg8::gemm_phase<EpiRes, SchedPlain>(lds, DM, S, E);
    }
    SEAM(6);

    if (IN(7)) {
        SchedPlain S{(const char*)HG, (const char*)Wt_up, 32, 32, DM, G, bid};
        EpiUp E{rowss, U};
        pg8::gemm_phase<EpiUp, SchedPlain>(lds, DM, S, E);
    }
    SEAM(7);

    if (IN(8)) {
        SchedPlain S{(const char*)U, (const char*)Wt_dn, 32, 8, FF, G, bid};
        EpiDown E{a.out, a.flags & 2};
        pg8::gemm_phase<EpiDown, SchedPlain>(lds, FF, S, E);
    }
#undef IN
#undef SEAM
}

extern "C" void kernel_launch(void* const* d_in, const int* in_sizes, int n_in, void* d_out, int out_size, void* d_ws, size_t ws_size, hipStream_t stream) {
    static int grid = 0;
    if (grid == 0) {
        if (n_in != 20 || ws_size < WS_END) { fprintf(stderr, "kernel_launch: unexpected inputs (n_in %d, ws %zu)\n", n_in, ws_size); grid = -1; return; }
        int dev = 0, cus = 0, per_cu = 0;
        hipGetDevice(&dev);
        hipDeviceGetAttribute(&cus, hipDeviceAttributeMultiprocessorCount, dev);
        if (hipFuncSetAttribute((const void*)fwd_kernel, hipFuncAttributeMaxDynamicSharedMemorySize, LDS_BYTES) != hipSuccess) { fprintf(stderr, "kernel_launch: hipFuncSetAttribute failed\n"); grid = -1; return; }
        if (hipOccupancyMaxActiveBlocksPerMultiprocessor(&per_cu, (const void*)fwd_kernel, NTHREADS, LDS_BYTES) != hipSuccess || per_cu < 1) { fprintf(stderr, "kernel_launch: occupancy query says %d\n", per_cu); per_cu = 1; }
        (void)hipGetLastError();
        grid = cus * per_cu;
    }
    if (grid < 0) return;
    Args a{};
    a.x = (const float*)d_in[0]; a.meta = (const float*)d_in[1]; a.norm1_g = (const float*)d_in[2]; a.w_in = (const float*)d_in[3];
    a.q_norm_g = (const float*)d_in[4]; a.k_norm_g = (const float*)d_in[5]; a.sinks = (const float*)d_in[6]; a.w_o_attn = (const float*)d_in[7];
    a.conv_w = (const float*)d_in[8]; a.conv_b = (const float*)d_in[9]; a.lru_wa = (const float*)d_in[10]; a.lru_ba = (const float*)d_in[11];
    a.lru_wi = (const float*)d_in[12]; a.lru_bi = (const float*)d_in[13]; a.lru_lambda = (const float*)d_in[14]; a.w_o_lru = (const float*)d_in[15];
    a.w_out = (const float*)d_in[16]; a.norm2_g = (const float*)d_in[17]; a.w_up = (const float*)d_in[18]; a.w_down = (const float*)d_in[19];
    a.out = (float*)d_out; a.ws = (unsigned char*)d_ws;
    if (hipMemsetAsync((unsigned char*)d_ws + WS_BAR, 0, WS_BAR_BYTES, stream) != hipSuccess) { fprintf(stderr, "kernel_launch: memset of the barrier words failed\n"); return; }
#if MK_MULTI
    for (int ph = 0; ph < 9; ++ph) {
        a.ph_lo = ph; a.ph_hi = ph + 1; a.flags = 0;
        void* args[] = {&a};
        hipError_t e = hipLaunchCooperativeKernel((const void*)fwd_kernel, dim3(grid), dim3(NTHREADS), args, LDS_BYTES, stream);
        if (e != hipSuccess) { fprintf(stderr, "cooperative launch (phase %d) failed: %s (grid %d)\n", ph, hipGetErrorString(e), grid); break; }
    }
#elif PROBE_DUP >= 0
    for (int li = 0; li < 2; ++li) {
        a.ph_lo = li ? PROBE_DUP : 0; a.ph_hi = li ? 9 : PROBE_DUP + 1; a.flags = (li << 8) | (li ? 0 : (PROBE_DUP == 6 ? 1 : (PROBE_DUP == 8 ? 2 : 0)));
        void* args[] = {&a};
        hipError_t e = hipLaunchCooperativeKernel((const void*)fwd_kernel, dim3(grid), dim3(NTHREADS), args, LDS_BYTES, stream);
        if (e != hipSuccess) { fprintf(stderr, "cooperative launch failed: %s (grid %d)\n", hipGetErrorString(e), grid); break; }
    }
#else
    a.ph_lo = 0; a.ph_hi = 9;
    void* args[] = {&a};
    hipError_t e = hipLaunchCooperativeKernel((const void*)fwd_kernel, dim3(grid), dim3(NTHREADS), args, LDS_BYTES, stream);
    if (e != hipSuccess) fprintf(stderr, "cooperative launch failed: %s (grid %d)\n", hipGetErrorString(e), grid);
#endif
}
```

```cpp
#include <hip/hip_runtime.h>
#include <hip/hip_cooperative_groups.h>
#include <cstdio>
#include <cstdint>
namespace cg = cooperative_groups;

#ifndef MK_MULTI
#define MK_MULTI 0
#endif

#ifndef PROBE_DUP
#define PROBE_DUP -1
#endif

#define LAS __attribute__((address_space(3)))
typedef unsigned short bf16_t;
typedef short bf16x8 __attribute__((ext_vector_type(8)));
typedef float f32x4 __attribute__((ext_vector_type(4)));
typedef float f32x2 __attribute__((ext_vector_type(2)));
typedef unsigned u32x4 __attribute__((ext_vector_type(4)));
typedef unsigned u32x2 __attribute__((ext_vector_type(2)));

constexpr int DM = 2048, NBATCH = 4, SEQ = 2048, MR = NBATCH * SEQ  , NMETA = 16, MPAD = 8448  ;
constexpr int INW = 10752, FF = 8192, KVW = 256;
constexpr float EPS = 1e-6f;
constexpr float LOG2E = 1.4426950408889634f;
constexpr int NTHREADS = 512, NWAVES = 8;
constexpr int LDS_BYTES = 147456;

constexpr size_t MiB = 1u << 20;
constexpr size_t WS_CTL = 0;
constexpr size_t WS_BAR = 65536, WS_BAR_BYTES = 65536;
constexpr size_t WS_R1 = 1 * MiB;
constexpr size_t WS_WTIN = WS_R1, WS_XN = WS_R1 + 42 * MiB;
constexpr size_t WS_WTUP = 272 * MiB, WS_WTDN = 304 * MiB;
constexpr size_t WS_WOA = 76 * MiB, WS_WOL = 84 * MiB, WS_WOUT = 92 * MiB, WS_WA = 100 * MiB, WS_WI = 101 * MiB;
constexpr size_t WS_Q = 102 * MiB;
constexpr size_t WS_K = 134 * MiB, WS_V = 134 * MiB + 4608 * 1024;
constexpr size_t WS_LX = 143 * MiB;
constexpr size_t WS_LG = 176 * MiB;
constexpr size_t WS_GA = 208 * MiB, WS_GL = 240 * MiB;
constexpr size_t WS_U = 143 * MiB;
#if PROBE_DUP == 3 || PROBE_DUP == 4
constexpr size_t WS_O = WS_R1, WS_REC = WS_R1 + 32 * MiB;
#else
constexpr size_t WS_O = WS_Q, WS_REC = WS_LG;
#endif
constexpr size_t WS_END = 336 * MiB;

typedef __bf16 bf16x2_t __attribute__((ext_vector_type(2)));
__device__ __forceinline__ unsigned cvt_pk_bf16(float lo, float hi) { const f32x2 v = {lo, hi}; const bf16x2_t b = __builtin_convertvector(v, bf16x2_t); return __builtin_bit_cast(unsigned, b); }
__device__ __forceinline__ float bf_lo(unsigned w) { return __uint_as_float(w << 16); }
__device__ __forceinline__ float bf_hi(unsigned w) { return __uint_as_float(w & 0xffff0000u); }
__device__ __forceinline__ float bf2f(bf16_t u) { return __uint_as_float((unsigned)u << 16); }
__device__ __forceinline__ float fast_sigmoid(float x) { return __builtin_amdgcn_rcpf(1.0f + __builtin_amdgcn_exp2f(-x * LOG2E)); }
__device__ __forceinline__ float gelu_tanh(float x) { const float y = 0.7978845608028654f * (x + 0.044715f * x * x * x); return x * __builtin_amdgcn_rcpf(1.0f + __builtin_amdgcn_exp2f(-2.0f * LOG2E * y)); }
#define LDS_WAIT() asm volatile("s_waitcnt lgkmcnt(0)" ::: "memory")
#define WG_BAR() do { asm volatile("s_waitcnt lgkmcnt(0)" ::: "memory"); __builtin_amdgcn_s_barrier(); asm volatile("" ::: "memory"); } while (0)

namespace pg8 {
constexpr int BM = 256, BK = 64, HALF = 128, HTB = HALF * BK * 2, STAGE_BYTES = 8 * HTB, NXCD = 8, WGM = 4;
__host__ __device__ __forceinline__ int lds_byte(int r, int c) { const int st = (r >> 4) * 2 + (c >> 5), rr = r & 15, cc = c & 31, ob = rr * 64 + cc * 2; return st * 1024 + (ob ^ (((ob >> 9) & 1) << 5)); }
__host__ __device__ __forceinline__ void stage_rc(int b, int& R, int& C) { const int st = b / 1024, sb = b % 1024, swz = sb ^ (((sb >> 9) & 1) << 5); R = (st >> 1) * 16 + swz / 64; C = (st & 1) * 32 + (swz % 64) / 2; }
__host__ __device__ __forceinline__ int perm32(int rho) { const int n = rho >> 4, i = rho & 15; return 8 * (i >> 2) + 4 * n + (i & 3); }

struct Unit { int pm, pn, sub; };

__device__ __forceinline__ void tile_of(int wgid, int nM, int nN, Unit& u) {
    const int nwg = nM * nN;
    { const int q = nwg / NXCD, r = nwg % NXCD, xcd = wgid % NXCD, off = wgid / NXCD; wgid = (xcd < r ? xcd * (q + 1) : r * (q + 1) + (xcd - r) * q) + off; }
    const int nig = WGM * nN, gid = wgid / nig, fm = gid * WGM, gsz = (nM - fm) < WGM ? (nM - fm) : WGM;
    u.pm = fm + ((wgid % nig) % gsz); u.pn = (wgid % nig) / gsz; u.sub = 0;
}

template <class Epi, class Sched, bool SPLITK = false>
__device__ __forceinline__ void gemm_phase(LAS unsigned char* lds, const int K, const Sched& S, const Epi& E) {
    const int tid = threadIdx.x, wid = __builtin_amdgcn_readfirstlane(tid >> 6), lane = tid & 63, wr = wid >> 2, wc = wid & 3, fr = lane & 15, fq = lane >> 4;
    const int nt = K / BK, nth = nt / 2, ld = SPLITK ? K / 2 : K;
    unsigned voffA[2], voffB[2];
#pragma unroll
    for (int i = 0; i < 2; ++i) { int R, C; stage_rc(tid * 16 + i * 8192, R, C); const int Rb = Epi::PERM ? ((R & ~31) + perm32(R & 31)) : R;
        voffA[i] = (unsigned)(R * ld + C) * 2u; voffB[i] = (unsigned)(Rb * ld + C) * 2u; }
    const size_t kstep = (size_t)(BK * 2);
    const size_t hstep = (size_t)HALF * ld * 2;
    const unsigned ldsw = (unsigned)wid * 1024u;
    const int aoff = lds_byte(wr * 64 + fr, fq * 8), boff = lds_byte(wc * 32 + fr, fq * 8);
#define PG8_SA(b, h) (((b) * 2 + (h)) * HTB)
#define PG8_SB(b, h) ((4 + (b) * 2 + (h)) * HTB)
#define PG8_STAGE(bufoff, gbase, voff) do { _Pragma("unroll") for (int _i = 0; _i < 2; ++_i) \
        __builtin_amdgcn_global_load_lds((const unsigned*)((const char*)(gbase) + (voff)[_i]), (LAS unsigned*)(lds + (bufoff) + ldsw + _i * 8192), 16, 0, 0); } while (0)
#define PG8_LDA(dst, b, h) do { _Pragma("unroll") for (int m = 0; m < 4; ++m) _Pragma("unroll") for (int k = 0; k < 2; ++k) dst[m][k] = *(const LAS bf16x8*)(lds + PG8_SA(b, h) + aoff + m * 2048 + k * 1024); } while (0)
#define PG8_LDB(dst, b, h) do { _Pragma("unroll") for (int n = 0; n < 2; ++n) _Pragma("unroll") for (int k = 0; k < 2; ++k) dst[n][k] = *(const LAS bf16x8*)(lds + PG8_SB(b, h) + boff + n * 2048 + k * 1024); } while (0)
#define PG8_MMA(ai, bj, At, Bt) do { __builtin_amdgcn_s_setprio(1); _Pragma("unroll") for (int m = 0; m < 4; ++m) _Pragma("unroll") for (int n = 0; n < 2; ++n) _Pragma("unroll") for (int k = 0; k < 2; ++k) \
        acc[ai][bj][m][n] = __builtin_amdgcn_mfma_f32_16x16x32_bf16(Bt[n][k], At[m][k], acc[ai][bj][m][n], 0, 0, 0); __builtin_amdgcn_s_setprio(0); } while (0)
#define PG8_WAIT_V(n) asm volatile("s_waitcnt vmcnt(" #n ")" ::: "memory")
#define PG8_WAIT_L(n) asm volatile("s_waitcnt lgkmcnt(" #n ")" ::: "memory")
#define PG8_BAR __builtin_amdgcn_s_barrier()
#define PG8_SCHED __builtin_amdgcn_sched_barrier(0)
    Unit cur, nxt; int ui = 0;
    if (!S.next(0, cur)) return;
    f32x4 acc[2][2][4][2];
    E.init(acc, cur, wr, wc, fr, fq);
    bf16x8 At[4][2], B0[2][2], B1[2][2];
    const char* cA = S.a_base(cur); const char* cB = S.b_base(cur);
    const char* cA2 = cA; const char* cB2 = cB;
    if constexpr (SPLITK) { cA2 = S.a_base2(cur); cB2 = S.b_base2(cur); }
#define PG8_KTA(j) ((SPLITK && (j) >= nth) ? cA2 + (size_t)((j) - nth) * kstep : cA + (size_t)(j) * kstep)
#define PG8_KTB(j) ((SPLITK && (j) >= nth) ? cB2 + (size_t)((j) - nth) * kstep : cB + (size_t)(j) * kstep)
    PG8_STAGE(PG8_SB(0, 0), cB, voffB); PG8_STAGE(PG8_SB(0, 1), cB + hstep, voffB); PG8_STAGE(PG8_SA(0, 0), cA, voffA); PG8_STAGE(PG8_SA(0, 1), cA + hstep, voffA);
    if (wr == 1) PG8_BAR;
    PG8_WAIT_V(2); PG8_BAR;
    PG8_STAGE(PG8_SB(1, 0), cB + kstep, voffB); PG8_STAGE(PG8_SA(1, 0), cA + kstep, voffA); PG8_STAGE(PG8_SB(1, 1), cB + hstep + kstep, voffB);
    PG8_WAIT_V(6); PG8_BAR;
    for (;;) {
        const bool has_next = S.next(ui + 1, nxt);
        const char* nA = has_next ? S.a_base(nxt) : cA; const char* nB = has_next ? S.b_base(nxt) : cB;
        for (int t = 0; t < nt; t += 2) {
            const bool last = (t == nt - 2);
            const char* a1 = PG8_KTA(t + 1);
            const char* a2 = last ? nA : PG8_KTA(t + 2); const char* b2 = last ? nB : PG8_KTB(t + 2);
            const char* a3 = last ? nA + kstep : PG8_KTA(t + 3); const char* b3 = last ? nB + kstep : PG8_KTB(t + 3);
            if constexpr (SPLITK) { if (t == nth) E.mid(acc, cur, wr, wc, fr, fq); }
            PG8_LDB(B0, 0, 0); PG8_LDB(B1, 0, 1); PG8_SCHED; PG8_LDA(At, 0, 0); PG8_STAGE(PG8_SA(1, 1), a1 + hstep, voffA);
            PG8_WAIT_V(8); PG8_WAIT_L(0); PG8_BAR; PG8_MMA(0, 0, At, B0); PG8_MMA(0, 1, At, B1); PG8_BAR; PG8_SCHED;
            PG8_LDA(At, 0, 1); PG8_STAGE(PG8_SB(0, 0), b2, voffB); PG8_STAGE(PG8_SB(0, 1), b2 + hstep, voffB); PG8_STAGE(PG8_SA(0, 0), a2, voffA);
            PG8_WAIT_V(8); PG8_WAIT_L(0); PG8_BAR; PG8_MMA(1, 0, At, B0); PG8_MMA(1, 1, At, B1); PG8_BAR; PG8_SCHED;
            PG8_LDB(B0, 1, 0); PG8_LDB(B1, 1, 1); PG8_SCHED; PG8_LDA(At, 1, 0); PG8_STAGE(PG8_SA(0, 1), a2 + hstep, voffA);
            PG8_WAIT_V(8); PG8_WAIT_L(0); PG8_BAR; PG8_MMA(0, 0, At, B0); PG8_MMA(0, 1, At, B1); PG8_BAR; PG8_SCHED;
            PG8_LDA(At, 1, 1); PG8_STAGE(PG8_SB(1, 0), b3, voffB); PG8_STAGE(PG8_SB(1, 1), b3 + hstep, voffB); PG8_STAGE(PG8_SA(1, 0), a3, voffA);
            PG8_WAIT_V(8); PG8_WAIT_L(0); PG8_BAR; PG8_MMA(1, 0, At, B0); PG8_MMA(1, 1, At, B1); PG8_BAR; PG8_SCHED;
        }
        if (wr == 0) PG8_BAR;
        E(acc, cur, wr, wc, fr, fq);
        if (!has_next) break;
        E.init(acc, nxt, wr, wc, fr, fq);
        cur = nxt; cA = nA; cB = nB; ++ui;
        if constexpr (SPLITK) { cA2 = S.a_base2(cur); cB2 = S.b_base2(cur); }
        if (wr == 1) PG8_BAR;
    }
    PG8_WAIT_V(0);
    PG8_BAR;
#undef PG8_KTA
#undef PG8_KTB
#undef PG8_SA
#undef PG8_SB
#undef PG8_STAGE
#undef PG8_LDA
#undef PG8_LDB
#undef PG8_MMA
#undef PG8_WAIT_V
#undef PG8_WAIT_L
#undef PG8_BAR
#undef PG8_SCHED
}
}
using pg8::Unit;

struct SchedIn {
    const char* A; const char* B; int G, c;
    __device__ __forceinline__ bool next(int i, Unit& u) const {
        const int L = i * G + c; constexpr int NREG = 32 * 42;
        if (L < NREG) { pg8::tile_of(L, 32, 42, u); return true; }
        if (L < NREG + 10) { u.pm = 32; u.pn = 8 + (L - NREG); u.sub = 0; return true; }
        return false;
    }
    __device__ __forceinline__ const char* a_base(const Unit& u) const { return A + (size_t)u.pm * (256u * DM * 2u); }
    __device__ __forceinline__ const char* b_base(const Unit& u) const { return B + (size_t)u.pn * (256u * DM * 2u); }
};
struct SchedMix {
    const char* A0; const char* A1; const char* B0; const char* B1; int G, c;
    __device__ __forceinline__ bool next(int i, Unit& u) const {
        const int L = i * G + c; if (L >= 32 * 8) return false;
        pg8::tile_of(L, 32, 8, u); return true;
    }
    __device__ __forceinline__ const char* a_base(const Unit& u) const { return A0 + (size_t)u.pm * (256u * DM * 2u); }
    __device__ __forceinline__ const char* b_base(const Unit& u) const { return B0 + (size_t)u.pn * (256u * DM * 2u); }
    __device__ __forceinline__ const char* a_base2(const Unit& u) const { return A1 + (size_t)u.pm * (256u * DM * 2u); }
    __device__ __forceinline__ const char* b_base2(const Unit& u) const { return B1 + (size_t)u.pn * (256u * DM * 2u); }
};
struct SchedPlain {
    const char* A; const char* B; int nM, nN, K, G, c;
    __device__ __forceinline__ bool next(int i, Unit& u) const {
        const int L = i * G + c; if (L >= nM * nN) return false;
        pg8::tile_of(L, nM, nN, u); return true;
    }
    __device__ __forceinline__ const char* a_base(const Unit& u) const { return A + (size_t)u.pm * 256u * (size_t)K * 2u; }
    __device__ __forceinline__ const char* b_base(const Unit& u) const { return B + (size_t)u.pn * 256u * (size_t)K * 2u; }
};

__device__ __forceinline__ void acc_zero(f32x4 (&acc)[2][2][4][2]) {
#pragma unroll
    for (int a = 0; a < 2; ++a)
#pragma unroll
        for (int b = 0; b < 2; ++b)
#pragma unroll
            for (int m = 0; m < 4; ++m)
#pragma unroll
                for (int n = 0; n < 2; ++n) acc[a][b][m][n] = (f32x4){0.f, 0.f, 0.f, 0.f};
}
#define EPI_ZERO_INIT __device__ __forceinline__ void init(f32x4 (&acc)[2][2][4][2], const Unit&, int, int, int, int) const { acc_zero(acc); }
__device__ __forceinline__ void acc_load_f32(f32x4 (&acc)[2][2][4][2], const float* src, const Unit& u, int wr, int wc, int fr, int fq) {
    const int row0 = u.pm * 256 + wr * 64 + fr, col0 = u.pn * 256 + wc * 32 + 4 * fq;
#pragma unroll
    for (int ai = 0; ai < 2; ++ai)
#pragma unroll
        for (int m = 0; m < 4; ++m) { const size_t off = (size_t)(row0 + ai * 128 + m * 16) * DM + col0;
#pragma unroll
            for (int bj = 0; bj < 2; ++bj)
#pragma unroll
                for (int n = 0; n < 2; ++n) acc[ai][bj][m][n] = __builtin_nontemporal_load((const f32x4*)(src + off + bj * 128 + n * 16)); }
}
struct EpiIn {
    static constexpr bool PERM = true;
    bf16_t *Q, *Kb, *Vb, *LX, *LG, *GA, *GL;
    EPI_ZERO_INIT
    __device__ __forceinline__ void operator()(const f32x4 (&acc)[2][2][4][2], const Unit& u, int wr, int wc, int fr, int fq) const {
        const int pn = u.pn; int mode = 0, ldc = DM, colt; bf16_t* base;
        if (pn < 8) { base = Q; colt = pn * 256; }
        else if (pn == 8) { base = Kb; ldc = KVW; colt = 0; }
        else if (pn == 9) { base = Vb; ldc = KVW; colt = 0; }
        else if (pn < 18) { base = LX; colt = (pn - 10) * 256; }
        else if (pn < 26) { base = LG; colt = (pn - 18) * 256; mode = 1; }
        else {
            const int row0g = u.pm * 256 + wr * 64 + fr, ch0 = (pn - 26) * 128 + wc * 32 + 8 * fq;
#pragma unroll
            for (int ai = 0; ai < 2; ++ai)
#pragma unroll
                for (int m = 0; m < 4; ++m) { const size_t off = (size_t)(row0g + ai * 128 + m * 16) * DM + ch0;
                    float sr[8], sl[8];
#pragma unroll
                    for (int e = 0; e < 4; ++e) { const float a0 = fast_sigmoid(acc[ai][0][m][0][e]), a1 = fast_sigmoid(acc[ai][0][m][1][e]); sl[e] = fast_sigmoid(acc[ai][1][m][0][e]); sl[4 + e] = fast_sigmoid(acc[ai][1][m][1][e]);
                        sr[e] = a0 * __builtin_amdgcn_rcpf(fmaxf(sl[e], 1e-30f)); sr[4 + e] = a1 * __builtin_amdgcn_rcpf(fmaxf(sl[4 + e], 1e-30f)); }
                    u32x4 wr4, wl4;
                    wr4.x = cvt_pk_bf16(sr[0], sr[1]); wr4.y = cvt_pk_bf16(sr[2], sr[3]); wr4.z = cvt_pk_bf16(sr[4], sr[5]); wr4.w = cvt_pk_bf16(sr[6], sr[7]);
                    wl4.x = cvt_pk_bf16(sl[0], sl[1]); wl4.y = cvt_pk_bf16(sl[2], sl[3]); wl4.z = cvt_pk_bf16(sl[4], sl[5]); wl4.w = cvt_pk_bf16(sl[6], sl[7]);
                    __builtin_nontemporal_store(wr4, (u32x4*)(GA + off)); __builtin_nontemporal_store(wl4, (u32x4*)(GL + off)); }
            return;
        }
        const int row0 = u.pm * 256 + wr * 64 + fr, col0 = colt + wc * 32 + 8 * fq;
        const bool islx = (pn >= 10 && pn < 18);
#pragma unroll
        for (int ai = 0; ai < 2; ++ai)
#pragma unroll
            for (int m = 0; m < 4; ++m) { const int row = row0 + ai * 128 + m * 16; int orow = row;
                if (islx) orow = (row < MR) ? row + 16 * ((row >> 11) + 1) : row - MR;
                bf16_t* rowp = base + (size_t)orow * ldc + col0;
                const bool metarow = islx && row >= MR; if (metarow && row >= MR + NMETA) continue;
#pragma unroll
                for (int bj = 0; bj < 2; ++bj) { f32x4 v0 = acc[ai][bj][m][0], v1 = acc[ai][bj][m][1];
                    if (mode == 1) {
#pragma unroll
                        for (int e = 0; e < 4; ++e) { v0[e] = gelu_tanh(v0[e]); v1[e] = gelu_tanh(v1[e]); } }
                    else if (mode == 2) {
#pragma unroll
                        for (int e = 0; e < 4; ++e) { v0[e] = fast_sigmoid(v0[e]); v1[e] = fast_sigmoid(v1[e]); } }
                    u32x4 w; w.x = cvt_pk_bf16(v0[0], v0[1]); w.y = cvt_pk_bf16(v0[2], v0[3]); w.z = cvt_pk_bf16(v1[0], v1[1]); w.w = cvt_pk_bf16(v1[2], v1[3]);
                    *(u32x4*)(rowp + bj * 128) = w;
                    if (metarow) { *(u32x4*)(rowp + (size_t)2064 * DM + bj * 128) = w; *(u32x4*)(rowp + (size_t)(2 * 2064) * DM + bj * 128) = w; *(u32x4*)(rowp + (size_t)(3 * 2064) * DM + bj * 128) = w; } } }
    }
};
struct EpiMix {
    static constexpr bool PERM = true;
    const bf16_t *GA, *GL; bf16_t* MIX;
    EPI_ZERO_INIT
    __device__ __forceinline__ void mid(f32x4 (&acc)[2][2][4][2], const Unit& u, int wr, int wc, int fr, int fq) const {
        const int row0 = u.pm * 256 + wr * 64 + fr, col0 = u.pn * 256 + wc * 32 + 8 * fq;
#pragma unroll
        for (int ai = 0; ai < 2; ++ai)
#pragma unroll
            for (int m = 0; m < 4; ++m) { const size_t off = (size_t)(row0 + ai * 128 + m * 16) * DM + col0;
#pragma unroll
                for (int bj = 0; bj < 2; ++bj) { const u32x4 aw = __builtin_nontemporal_load((const u32x4*)(GA + off + bj * 128));
                    const float ra[8] = {bf_lo(aw.x), bf_hi(aw.x), bf_lo(aw.y), bf_hi(aw.y), bf_lo(aw.z), bf_hi(aw.z), bf_lo(aw.w), bf_hi(aw.w)};
#pragma unroll
                    for (int e = 0; e < 4; ++e) { acc[ai][bj][m][0][e] *= ra[e]; acc[ai][bj][m][1][e] *= ra[4 + e]; } } }
    }
    __device__ __forceinline__ void operator()(const f32x4 (&acc)[2][2][4][2], const Unit& u, int wr, int wc, int fr, int fq) const {
        const int row0 = u.pm * 256 + wr * 64 + fr, col0 = u.pn * 256 + wc * 32 + 8 * fq;
#pragma unroll
        for (int ai = 0; ai < 2; ++ai)
#pragma unroll
            for (int m = 0; m < 4; ++m) { const size_t off = (size_t)(row0 + ai * 128 + m * 16) * DM + col0;
#pragma unroll
                for (int bj = 0; bj < 2; ++bj) { const f32x4 a0 = acc[ai][bj][m][0], a1 = acc[ai][bj][m][1];
                    const u32x4 gw = __builtin_nontemporal_load((const u32x4*)(GL + off + bj * 128));
                    u32x4 w; w.x = cvt_pk_bf16(a0[0] * bf_lo(gw.x), a0[1] * bf_hi(gw.x)); w.y = cvt_pk_bf16(a0[2] * bf_lo(gw.y), a0[3] * bf_hi(gw.y));
                    w.z = cvt_pk_bf16(a1[0] * bf_lo(gw.z), a1[1] * bf_hi(gw.z)); w.w = cvt_pk_bf16(a1[2] * bf_lo(gw.w), a1[3] * bf_hi(gw.w));
                    *(u32x4*)(MIX + off + bj * 128) = w; } }
    }
};
struct EpiRes {
    static constexpr bool PERM = false;
    const float* x; const float* g2; float* out; bf16_t* HG; float* rowss; int noatom;
    __device__ __forceinline__ void init(f32x4 (&acc)[2][2][4][2], const Unit& u, int wr, int wc, int fr, int fq) const { acc_load_f32(acc, x, u, wr, wc, fr, fq); }
    __device__ __forceinline__ void operator()(const f32x4 (&acc)[2][2][4][2], const Unit& u, int wr, int wc, int fr, int fq) const {
        const int row0 = u.pm * 256 + wr * 64 + fr, col0 = u.pn * 256 + wc * 32 + 4 * fq;
        f32x4 gv[2][2];
#pragma unroll
        for (int bj = 0; bj < 2; ++bj)
#pragma unroll
            for (int n = 0; n < 2; ++n) gv[bj][n] = *(const f32x4*)(g2 + col0 + bj * 128 + n * 16);
#pragma unroll
        for (int ai = 0; ai < 2; ++ai)
#pragma unroll
            for (int m = 0; m < 4; ++m) { const int row = row0 + ai * 128 + m * 16; const size_t off = (size_t)row * DM + col0; float ss = 0.f;
#pragma unroll
                for (int bj = 0; bj < 2; ++bj)
#pragma unroll
                    for (int n = 0; n < 2; ++n) { const f32x4 h = acc[ai][bj][m][n];
                        __builtin_nontemporal_store(h, (f32x4*)(out + off + bj * 128 + n * 16));
                        ss += (h[0] * h[0] + h[1] * h[1]) + (h[2] * h[2] + h[3] * h[3]);
                        const f32x4 hg = h * gv[bj][n]; u32x2 w; w.x = cvt_pk_bf16(hg[0], hg[1]); w.y = cvt_pk_bf16(hg[2], hg[3]);
                        *(u32x2*)(HG + off + bj * 128 + n * 16) = w; }
                ss += __shfl_xor(ss, 16); ss += __shfl_xor(ss, 32);
                if (fq == 0 && !noatom) atomicAdd(rowss + row, ss); }
    }
};
struct EpiUp {
    static constexpr bool PERM = true;
    const float* rowss; bf16_t* U;
    EPI_ZERO_INIT
    __device__ __forceinline__ void operator()(const f32x4 (&acc)[2][2][4][2], const Unit& u, int wr, int wc, int fr, int fq) const {
        const int row0 = u.pm * 256 + wr * 64 + fr, col0 = u.pn * 256 + wc * 32 + 8 * fq;
#pragma unroll
        for (int ai = 0; ai < 2; ++ai)
#pragma unroll
            for (int m = 0; m < 4; ++m) { const int row = row0 + ai * 128 + m * 16; const float rs = __builtin_amdgcn_rsqf(rowss[row] * (1.0f / DM) + EPS);
                bf16_t* rowp = U + (size_t)row * FF + col0;
#pragma unroll
                for (int bj = 0; bj < 2; ++bj) { f32x4 v0 = acc[ai][bj][m][0] * rs, v1 = acc[ai][bj][m][1] * rs;
#pragma unroll
                    for (int e = 0; e < 4; ++e) { const float a = fmaxf(v0[e], 0.f), b = fmaxf(v1[e], 0.f); v0[e] = a * a; v1[e] = b * b; }
                    u32x4 w; w.x = cvt_pk_bf16(v0[0], v0[1]); w.y = cvt_pk_bf16(v0[2], v0[3]); w.z = cvt_pk_bf16(v1[0], v1[1]); w.w = cvt_pk_bf16(v1[2], v1[3]);
                    *(u32x4*)(rowp + bj * 128) = w; } }
    }
};
struct EpiDown {
    static constexpr bool PERM = false;
    float* out; int nostore;
    __device__ __forceinline__ void init(f32x4 (&acc)[2][2][4][2], const Unit& u, int wr, int wc, int fr, int fq) const { acc_load_f32(acc, out, u, wr, wc, fr, fq); }
    __device__ __forceinline__ void operator()(const f32x4 (&acc)[2][2][4][2], const Unit& u, int wr, int wc, int fr, int fq) const {
        const int row0 = u.pm * 256 + wr * 64 + fr, col0 = u.pn * 256 + wc * 32 + 4 * fq;
#pragma unroll
        for (int ai = 0; ai < 2; ++ai)
#pragma unroll
            for (int m = 0; m < 4; ++m) { const size_t off = (size_t)(row0 + ai * 128 + m * 16) * DM + col0;
#pragma unroll
                for (int bj = 0; bj < 2; ++bj)
#pragma unroll
                    for (int n = 0; n < 2; ++n) { float* p = out + off + bj * 128 + n * 16; if (!nostore) __builtin_nontemporal_store(acc[ai][bj][m][n], (f32x4*)p); } }
    }
};

struct Args {
    const float *x, *meta, *norm1_g, *w_in, *q_norm_g, *k_norm_g, *sinks, *w_o_attn, *conv_w, *conv_b, *lru_wa, *lru_ba, *lru_wi, *lru_bi, *lru_lambda, *w_o_lru, *w_out, *norm2_g, *w_up, *w_down;
    float* out; unsigned char* ws; int ph_lo, ph_hi, flags, pad;
};

__device__ __forceinline__ float wave_sum(float v) {
#pragma unroll
    for (int o = 1; o < 64; o <<= 1) v += __shfl_xor(v, o);
    return v;
}
__device__ __forceinline__ void transpose_load(f32x4 (&v)[16], const float* __restrict__ W, int N, int item, int lane) {
    const int nblk = N >> 6, kb = item / nblk, nb = item - kb * nblk, k0 = kb * 64, n0 = nb * 64;
    const int lr = lane >> 4, lc = (lane & 15) * 4;
    const unsigned off0 = (unsigned)((k0 + lr) * N + n0 + lc), rstep = (unsigned)(4 * N);
#pragma unroll
    for (int i = 0; i < 16; ++i) v[i] = __builtin_nontemporal_load((const f32x4*)(W + (off0 + (unsigned)i * rstep)));
}
template <bool NT = false> __device__ __forceinline__ void transpose_store(const f32x4 (&v)[16], int K, int N, bf16_t* __restrict__ WT, int row_off, LAS float* scr, int item, int lane) {
    const int nblk = N >> 6, kb = item / nblk, nb = item - kb * nblk, k0 = kb * 64, n0 = nb * 64;
    const int lr = lane >> 4, lc = (lane & 15) * 4;
#pragma unroll
    for (int i = 0; i < 16; ++i) { LAS float* s = scr + (4 * i + lr) * 65 + lc; s[0] = v[i][0]; s[1] = v[i][1]; s[2] = v[i][2]; s[3] = v[i][3]; }
    LDS_WAIT(); asm volatile("" ::: "memory");
    const int c = lane & 7, ns = lane >> 3;
    bf16_t* wp = WT + (size_t)(row_off + n0 + ns) * K + k0 + 8 * c; const size_t wstep = (size_t)8 * K;
#pragma unroll
    for (int j = 0; j < 8; ++j) { const LAS float* s = scr + (8 * c) * 65 + ns + 8 * j;
        u32x4 o; o.x = cvt_pk_bf16(s[0 * 65], s[1 * 65]); o.y = cvt_pk_bf16(s[2 * 65], s[3 * 65]); o.z = cvt_pk_bf16(s[4 * 65], s[5 * 65]); o.w = cvt_pk_bf16(s[6 * 65], s[7 * 65]);
        if (NT) __builtin_nontemporal_store(o, (u32x4*)wp); else *(u32x4*)wp = o;
        wp += wstep; asm volatile("" : "+v"(wp)); }
    LDS_WAIT(); asm volatile("" ::: "memory");
}
__device__ __forceinline__ void transpose_item(const float* __restrict__ W, int K, int N, bf16_t* __restrict__ WT, int row_off, LAS float* scr, int item, int lane) {
    f32x4 v[16]; transpose_load(v, W, N, item, lane); transpose_store(v, K, N, WT, row_off, scr, item, lane);
}
__device__ __forceinline__ void rms_row_to_bf16(const float* xrow, const float* g, bf16_t* orow, int lane) {
    const f32x4* xr = (const f32x4*)xrow + lane; const f32x4* gr = (const f32x4*)g + lane;
    f32x4 v[8], gv[8]; float s = 0.f;
#pragma unroll
    for (int j = 0; j < 8; ++j) { v[j] = xr[64 * j]; gv[j] = gr[64 * j]; }
#pragma unroll
    for (int j = 0; j < 8; ++j) s += (v[j][0] * v[j][0] + v[j][1] * v[j][1]) + (v[j][2] * v[j][2] + v[j][3] * v[j][3]);
    const float rs = 1.0f / sqrtf(wave_sum(s) * (1.0f / DM) + EPS);
    u32x2* o8 = (u32x2*)orow + lane;
#pragma unroll
    for (int j = 0; j < 8; ++j) { const f32x4 gg = gv[j]; u32x2 w; w.x = cvt_pk_bf16(v[j][0] * rs * gg[0], v[j][1] * rs * gg[1]); w.y = cvt_pk_bf16(v[j][2] * rs * gg[2], v[j][3] * rs * gg[3]); o8[64 * j] = w; }
}


#define XB_TMO      128
#define XB_XCNT(j)  (256  + 64 * (j))
#define XB_XSUB(j)  (1280 + 64 * (j))
#define XB_XGEN(j)  (2304 + 64 * (j))
#define XB_TOP      3328
#define XB_TOPGEN   3392
#define XCD_BAR_WORDS 3456
#define XB_SPIN_CAP (1u << 18)
__device__ __forceinline__ unsigned xb_ld(unsigned* p)              { return __hip_atomic_load(p, __ATOMIC_RELAXED, __HIP_MEMORY_SCOPE_AGENT); }
__device__ __forceinline__ unsigned xb_add(unsigned* p, unsigned v) { return __hip_atomic_fetch_add(p, v, __ATOMIC_RELAXED, __HIP_MEMORY_SCOPE_AGENT); }
__device__ __forceinline__ unsigned xb_xcc_id() { return (unsigned)__builtin_amdgcn_s_getreg((3 << 11) | 20) & 0xFu; }
#define XB_SPIN(cond, bar) do { unsigned _sp = 0; while (cond) { __builtin_amdgcn_s_sleep(1); \
    if ((++_sp & 255u) == 0u) { if (xb_ld(&(bar)[XB_TMO])) break; if (_sp > XB_SPIN_CAP) { atomicAdd(&(bar)[XB_TMO], 1u); break; } } } } while (0)
struct XcdBarrier { unsigned* bar; unsigned x; volatile LAS unsigned* st; };
__device__ __forceinline__ XcdBarrier xcd_barrier_post(unsigned* bar, volatile LAS unsigned* st) {
    XcdBarrier b; b.bar = bar; b.x = xb_xcc_id(); b.st = st;
    if (threadIdx.x == 0) (void)xb_add(&bar[XB_XCNT(b.x)], 1u);
    return b;
}
__device__ __forceinline__ void xcd_barrier_complete(unsigned* bar, unsigned x, unsigned& nloc, unsigned& nx) {
    const unsigned G = gridDim.x * gridDim.y * gridDim.z;
    unsigned sum, cnt, mine, sp = 0u;
    for (;;) {
        sum = 0u; cnt = 0u; mine = 0u;
#pragma unroll
        for (unsigned j = 0; j < 16; ++j) { const unsigned c = xb_ld(&bar[XB_XCNT(j)]); sum += c; cnt += (c > 0u) ? 1u : 0u; mine = (j == x) ? c : mine; }
        if (sum == G) break;
        __builtin_amdgcn_s_sleep(1);
        if ((++sp & 255u) == 0u) { if (xb_ld(&bar[XB_TMO])) break; if (sp > XB_SPIN_CAP) { atomicAdd(&bar[XB_TMO], 1u); break; } }
    }
    nloc = mine > 0u ? mine : 1u; nx = cnt > 0u ? cnt : 1u;
}
__device__ __forceinline__ void xcd_barrier(const XcdBarrier& b) {
    asm volatile("s_waitcnt vmcnt(0)" ::: "memory");
    __syncthreads();
    if (threadIdx.x == 0) {
        unsigned* bar = b.bar;
        __builtin_amdgcn_s_waitcnt(0);
        unsigned nloc = b.st[0], nx = b.st[1];
        if (nloc == 0u) { xcd_barrier_complete(bar, b.x, nloc, nx); b.st[0] = nloc; b.st[1] = nx; }
        const unsigned old = xb_add(&bar[XB_XSUB(b.x)], 1u);
        const unsigned gen = old / nloc;
        if (old + 1u == (gen + 1u) * nloc) {
            __builtin_amdgcn_fence(__ATOMIC_RELEASE, "agent");
            asm volatile("s_waitcnt vmcnt(0)" ::: "memory");
            const unsigned og = xb_add(&bar[XB_TOP], 1u);
            const unsigned tg = og / nx;
            if (og + 1u == (tg + 1u) * nx) xb_add(&bar[XB_TOPGEN], 1u);
            else XB_SPIN(xb_ld(&bar[XB_TOPGEN]) == tg, bar);
            __builtin_amdgcn_fence(__ATOMIC_ACQUIRE, "agent");
            xb_add(&bar[XB_XGEN(b.x)], 1u);
            asm volatile("s_waitcnt vmcnt(0)" ::: "memory");
        } else {
            XB_SPIN(xb_ld(&bar[XB_XGEN(b.x)]) == gen, bar);
            __builtin_amdgcn_fence(__ATOMIC_ACQUIRE, "agent");
            asm volatile("s_waitcnt vmcnt(0)" ::: "memory");
        }
    }
    __syncthreads();
}

__global__ void __launch_bounds__(NTHREADS, 2) fwd_kernel(Args a) {
    extern __shared__ __attribute__((aligned(16))) unsigned char lds_raw[];
    LAS unsigned char* lds = (LAS unsigned char*)lds_raw;
    const int tid = threadIdx.x, lane = tid & 63, wave = __builtin_amdgcn_readfirstlane(tid >> 6);
    const int G = gridDim.x, bid = blockIdx.x;
    unsigned char* ws = a.ws;
    float* rowss = (float*)(ws + WS_CTL);
    bf16_t* Wt_in = (bf16_t*)(ws + WS_WTIN); bf16_t* XN = (bf16_t*)(ws + WS_XN);
    bf16_t* Wt_up = (bf16_t*)(ws + WS_WTUP); bf16_t* Wt_dn = (bf16_t*)(ws + WS_WTDN);
    bf16_t* Wt_oa = (bf16_t*)(ws + WS_WOA); bf16_t* Wt_ol = (bf16_t*)(ws + WS_WOL); bf16_t* Wt_out = (bf16_t*)(ws + WS_WOUT);
    bf16_t* Wt_a = (bf16_t*)(ws + WS_WA); bf16_t* Wt_i = (bf16_t*)(ws + WS_WI);
    bf16_t* Qb = (bf16_t*)(ws + WS_Q); bf16_t* Kb = (bf16_t*)(ws + WS_K); bf16_t* Vb = (bf16_t*)(ws + WS_V);
    bf16_t* LX = (bf16_t*)(ws + WS_LX); bf16_t* LG = (bf16_t*)(ws + WS_LG); bf16_t* GA = (bf16_t*)(ws + WS_GA); bf16_t* GL = (bf16_t*)(ws + WS_GL);
    bf16_t* MIX = LX; bf16_t* HG = Qb; bf16_t* U = (bf16_t*)(ws + WS_U); bf16_t* Ob = (bf16_t*)(ws + WS_O); bf16_t* REC = (bf16_t*)(ws + WS_REC);
    const int lo = a.ph_lo, hi = a.ph_hi;
#define IN(k) (lo <= (k) && (k) < hi)
    volatile LAS unsigned* bst = (volatile LAS unsigned*)(lds + LDS_BYTES - 16);
    if (tid < 4) bst[tid] = 0u;
    __syncthreads();
    const XcdBarrier xbar = xcd_barrier_post((unsigned*)(ws + WS_BAR) + (a.flags >> 8) * XCD_BAR_WORDS, bst);
#define SEAM(k) do { if (IN(k) && IN((k) + 1)) { xcd_barrier(xbar); } } while (0)
    if (a.ph_lo < 0) cg::this_grid().sync();

    if (IN(0)) {
        LAS float* scr = (LAS float*)(lds + wave * 16640);
        const int gw = bid * NWAVES + wave, NGW = G * NWAVES;
        constexpr int I_IN = 32 * 168, NITEMS = I_IN;
#define P0_DESC(IT, W_, K_, N_, WT_, RO_, LI_) do { int r_ = (IT) < NITEMS ? (IT) : NITEMS - 1;   \
            { const int n0_ = (r_ % (INW / 64)) * 64; int ro_ = 0;     \
                if (n0_ >= 6656) { const int c_ = n0_ - 6656, isgl_ = c_ >> 11, cc_ = c_ & 2047; ro_ = 6656 + (cc_ >> 7) * 256 + isgl_ * 128 + (cc_ & 127) - n0_; } \
                W_ = a.w_in; K_ = DM; N_ = INW; WT_ = Wt_in; RO_ = ro_; LI_ = r_; } } while (0)
        {
            f32x4 va[16], vb[16], vc[16];
            const float* wA; bf16_t* tA; int kA, nA, rA, lA; const float* wB; bf16_t* tB; int kB, nB, rB, lB; const float* wC; bf16_t* tC; int kC, nC, rC, lC;
            P0_DESC(gw, wA, kA, nA, tA, rA, lA); transpose_load(va, wA, nA, lA, lane);
            P0_DESC(gw + NGW, wB, kB, nB, tB, rB, lB); transpose_load(vb, wB, nB, lB, lane);
#pragma unroll 1
            for (int it = gw; it < NITEMS; it += 3 * NGW) {
                P0_DESC(it + 2 * NGW, wC, kC, nC, tC, rC, lC); transpose_load(vc, wC, nC, lC, lane);
                transpose_store(va, kA, nA, tA, rA, scr, lA, lane);
                P0_DESC(it + 3 * NGW, wA, kA, nA, tA, rA, lA); transpose_load(va, wA, nA, lA, lane);
                transpose_store(vb, kB, nB, tB, rB, scr, lB, lane);
                P0_DESC(it + 4 * NGW, wB, kB, nB, tB, rB, lB); transpose_load(vb, wB, nB, lB, lane);
                transpose_store(vc, kC, nC, tC, rC, scr, lC, lane);
            }
        }
#undef P0_DESC
        {
            const f32x4* gr = (const f32x4*)a.norm1_g + lane; f32x4 gv[8];
#pragma unroll
            for (int j = 0; j < 8; ++j) gv[j] = gr[64 * j];
#define P0_ROWSRC(M) ((M) < MR ? a.x + (size_t)(M) * DM : a.meta + (size_t)(((M) < MR + NMETA ? (M) : MR + NMETA - 1) - MR) * DM)
            f32x4 vn[8];
            { const f32x4* xr = (const f32x4*)P0_ROWSRC(gw) + lane;
#pragma unroll
              for (int j = 0; j < 8; ++j) vn[j] = __builtin_nontemporal_load(xr + 64 * j); }
#pragma unroll 1
            for (int m = gw; m < MR + NMETA; m += NGW) {
                f32x4 v[8];
#pragma unroll
                for (int j = 0; j < 8; ++j) v[j] = vn[j];
                { const f32x4* xr = (const f32x4*)P0_ROWSRC(m + NGW) + lane;
#pragma unroll
                  for (int j = 0; j < 8; ++j) vn[j] = __builtin_nontemporal_load(xr + 64 * j); }
                float ssq = 0.f;
#pragma unroll
                for (int j = 0; j < 8; ++j) ssq += (v[j][0] * v[j][0] + v[j][1] * v[j][1]) + (v[j][2] * v[j][2] + v[j][3] * v[j][3]);
                const float rs = 1.0f / sqrtf(wave_sum(ssq) * (1.0f / DM) + EPS);
                u32x2* o8 = (u32x2*)(XN + (size_t)m * DM) + lane;
#pragma unroll
                for (int j = 0; j < 8; ++j) { u32x2 w; w.x = cvt_pk_bf16(v[j][0] * rs * gv[j][0], v[j][1] * rs * gv[j][1]); w.y = cvt_pk_bf16(v[j][2] * rs * gv[j][2], v[j][3] * rs * gv[j][3]); o8[64 * j] = w; }
            }
#undef P0_ROWSRC
            for (int m = MR + NMETA + gw; m < MPAD; m += NGW) { u32x4* o = (u32x4*)(XN + (size_t)m * DM) + lane;
#pragma unroll
                for (int j = 0; j < 4; ++j) o[64 * j] = (u32x4){0u, 0u, 0u, 0u}; }
        }
        for (int i = bid * NTHREADS + tid; i < MR; i += G * NTHREADS) rowss[i] = 0.f;
    }
    SEAM(0);

    if (IN(1)) {
        const int NT_CU = (G >= 128) ? (G * 30) / 256 : 0, NG = G - NT_CU;
        if (bid < NG) {
            SchedIn S{(const char*)XN, (const char*)Wt_in, NG, bid};
            EpiIn E{Qb, Kb, Vb, LX, LG, GA, GL};
            pg8::gemm_phase<EpiIn, SchedIn>(lds, DM, S, E);
        }
        if (bid >= NG || NT_CU == 0) {
            LAS float* scr = (LAS float*)(lds + wave * 16640);
            const int gw = (NT_CU ? bid - NG : bid) * NWAVES + wave, NGW = (NT_CU ? NT_CU : G) * NWAVES;
            constexpr int I_UP = 32 * 128, I_DN = 128 * 32, I_SQ1 = 32 * 32, I_LRU1 = 16 * 16, NIT = I_UP + I_DN + 3 * I_SQ1 + I_LRU1;
#define P1_DESC(IT, W_, K_, N_, WT_, LI_) do { const int r_ = (IT) < NIT ? (IT) : NIT - 1;   \
                if (r_ < I_UP) { W_ = a.w_up; K_ = DM; N_ = FF; WT_ = Wt_up; LI_ = r_; } \
                else if (r_ < I_UP + I_DN) { W_ = a.w_down; K_ = FF; N_ = DM; WT_ = Wt_dn; LI_ = r_ - I_UP; } \
                else if (r_ < I_UP + I_DN + I_SQ1) { W_ = a.w_o_attn; K_ = DM; N_ = DM; WT_ = Wt_oa; LI_ = r_ - I_UP - I_DN; } \
                else if (r_ < I_UP + I_DN + 2 * I_SQ1) { W_ = a.w_o_lru; K_ = DM; N_ = DM; WT_ = Wt_ol; LI_ = r_ - I_UP - I_DN - I_SQ1; } \
                else if (r_ < I_UP + I_DN + 3 * I_SQ1) { W_ = a.w_out; K_ = DM; N_ = DM; WT_ = Wt_out; LI_ = r_ - I_UP - I_DN - 2 * I_SQ1; } \
                else { const int q_ = r_ - I_UP - I_DN - 3 * I_SQ1, mat_ = q_ >> 4, which_ = mat_ >> 3, n_ = mat_ & 7;     \
                    W_ = (which_ ? a.lru_wi : a.lru_wa) + (size_t)n_ * 65536; K_ = 256; N_ = 256; WT_ = (which_ ? Wt_i : Wt_a) + (size_t)n_ * 65536; LI_ = q_ & 15; } } while (0)
            f32x4 va[16], vb[16];
            const float* wA; bf16_t* tA; int kA, nA, lA; const float* wB; bf16_t* tB; int kB, nB, lB;
            P1_DESC(gw, wA, kA, nA, tA, lA); transpose_load(va, wA, nA, lA, lane);
#pragma unroll 1
            for (int it = gw; it < NIT; it += 2 * NGW) {
                P1_DESC(it + NGW, wB, kB, nB, tB, lB); transpose_load(vb, wB, nB, lB, lane);
                transpose_store<true>(va, kA, nA, tA, 0, scr, lA, lane);
                P1_DESC(it + 2 * NGW, wA, kA, nA, tA, lA); transpose_load(va, wA, nA, lA, lane);
                transpose_store<true>(vb, kB, nB, tB, 0, scr, lB, lane);
            }
#undef P1_DESC
        }
    }
    SEAM(1);

    {
        if (IN(3)) {
            constexpr int KS_STRIDE = 144  , VT_STRIDE = 552  , VT_OFF = 39424;
            const int fr = lane & 15, fq = lane >> 4;
            for (int ub = bid; ub < 256; ub += G) {
                const int vu = (G == 256) ? (ub & 7) * 32 + (ub >> 3) : ub;
                const int b = vu >> 6, g = (vu >> 4) & 3, qb = vu & 15;
                {
                    const int ch = tid & 7;
                    float gk[8];
#pragma unroll
                    for (int e = 0; e < 8; ++e) gk[e] = a.k_norm_g[ch * 8 + e];
                    u32x4 kws[5], vws[5];
#pragma unroll
                    for (int it = 0; it < 5; ++it) {
                        const int key = (it * NTHREADS + tid) >> 3;
                        bool ld = key < 272; int row = 0;
                        if (key < 16) row = MR + key;
                        else { const int ik = key - 16; row = b * SEQ + qb * 128 - 128 + ik; if (qb == 0 && ik < 128) ld = false; }
                        kws[it] = (u32x4){0u, 0u, 0u, 0u}; vws[it] = (u32x4){0u, 0u, 0u, 0u};
                        if (ld) { kws[it] = *(const u32x4*)(Kb + (size_t)row * KVW + g * 64 + ch * 8); vws[it] = *(const u32x4*)(Vb + (size_t)row * KVW + g * 64 + ch * 8); }
                    }
#pragma unroll
                    for (int it = 0; it < 5; ++it) {
                        const int key = (it * NTHREADS + tid) >> 3;
                        const u32x4 kw = kws[it], vw = vws[it];
                        float kf[8] = {bf_lo(kw.x), bf_hi(kw.x), bf_lo(kw.y), bf_hi(kw.y), bf_lo(kw.z), bf_hi(kw.z), bf_lo(kw.w), bf_hi(kw.w)};
                        float ss = 0.f;
#pragma unroll
                        for (int e = 0; e < 8; ++e) ss += kf[e] * kf[e];
                        ss += __shfl_xor(ss, 1); ss += __shfl_xor(ss, 2); ss += __shfl_xor(ss, 4);
                        const float sc = 1.0f / sqrtf(ss * (1.0f / 64.0f) + EPS);
                        if (key < 272) {
                            u32x4 o; o.x = cvt_pk_bf16(kf[0] * sc * gk[0], kf[1] * sc * gk[1]); o.y = cvt_pk_bf16(kf[2] * sc * gk[2], kf[3] * sc * gk[3]);
                            o.z = cvt_pk_bf16(kf[4] * sc * gk[4], kf[5] * sc * gk[5]); o.w = cvt_pk_bf16(kf[6] * sc * gk[6], kf[7] * sc * gk[7]);
                            *(LAS u32x4*)(lds + key * KS_STRIDE + ch * 16) = o;
                            LAS bf16_t* vt = (LAS bf16_t*)(lds + VT_OFF + (ch * 8) * VT_STRIDE + key * 2);
                            vt[0 * (VT_STRIDE / 2)] = (bf16_t)(vw.x & 0xffffu); vt[1 * (VT_STRIDE / 2)] = (bf16_t)(vw.x >> 16);
                            vt[2 * (VT_STRIDE / 2)] = (bf16_t)(vw.y & 0xffffu); vt[3 * (VT_STRIDE / 2)] = (bf16_t)(vw.y >> 16);
                            vt[4 * (VT_STRIDE / 2)] = (bf16_t)(vw.z & 0xffffu); vt[5 * (VT_STRIDE / 2)] = (bf16_t)(vw.z >> 16);
                            vt[6 * (VT_STRIDE / 2)] = (bf16_t)(vw.w & 0xffffu); vt[7 * (VT_STRIDE / 2)] = (bf16_t)(vw.w >> 16);
                        }
                    }
                }
                __syncthreads();
                const int h = g * 8 + wave;
                const float sinkl = a.sinks[h] * LOG2E;
                float gq[16];
#pragma unroll
                for (int e = 0; e < 8; ++e) { gq[e] = a.q_norm_g[8 * fq + e]; gq[8 + e] = a.q_norm_g[32 + 8 * fq + e]; }
                u32x4 q0n, q1n;
                { const bf16_t* qp0 = Qb + (size_t)(b * SEQ + qb * 128 + fr) * DM + h * 64; q0n = *(const u32x4*)(qp0 + 8 * fq); q1n = *(const u32x4*)(qp0 + 32 + 8 * fq); }
#pragma unroll 1
                for (int mt = 0; mt < 8; ++mt) {
                    const size_t qrow = (size_t)(b * SEQ + qb * 128 + mt * 16 + fr);
                    const u32x4 q0 = q0n, q1 = q1n;
                    { const bf16_t* qpn = Qb + (qrow + (mt < 7 ? 16 : 0)) * DM + h * 64; q0n = *(const u32x4*)(qpn + 8 * fq); q1n = *(const u32x4*)(qpn + 32 + 8 * fq); }
                    float qf[16] = {bf_lo(q0.x), bf_hi(q0.x), bf_lo(q0.y), bf_hi(q0.y), bf_lo(q0.z), bf_hi(q0.z), bf_lo(q0.w), bf_hi(q0.w),
                                    bf_lo(q1.x), bf_hi(q1.x), bf_lo(q1.y), bf_hi(q1.y), bf_lo(q1.z), bf_hi(q1.z), bf_lo(q1.w), bf_hi(q1.w)};
                    float ss = 0.f;
#pragma unroll
                    for (int e = 0; e < 16; ++e) ss += qf[e] * qf[e];
                    ss += __shfl_xor(ss, 16); ss += __shfl_xor(ss, 32);
                    const float sc = (0.125f * LOG2E) / sqrtf(ss * (1.0f / 64.0f) + EPS);
                    u32x4 qa, qc;
                    qa.x = cvt_pk_bf16(qf[0] * sc * gq[0], qf[1] * sc * gq[1]); qa.y = cvt_pk_bf16(qf[2] * sc * gq[2], qf[3] * sc * gq[3]);
                    qa.z = cvt_pk_bf16(qf[4] * sc * gq[4], qf[5] * sc * gq[5]); qa.w = cvt_pk_bf16(qf[6] * sc * gq[6], qf[7] * sc * gq[7]);
                    qc.x = cvt_pk_bf16(qf[8] * sc * gq[8], qf[9] * sc * gq[9]); qc.y = cvt_pk_bf16(qf[10] * sc * gq[10], qf[11] * sc * gq[11]);
                    qc.z = cvt_pk_bf16(qf[12] * sc * gq[12], qf[13] * sc * gq[13]); qc.w = cvt_pk_bf16(qf[14] * sc * gq[14], qf[15] * sc * gq[15]);
                    const bf16x8 qfr0 = __builtin_bit_cast(bf16x8, qa), qfr1 = __builtin_bit_cast(bf16x8, qc);
                    f32x4 st[10];
#pragma unroll
                    for (int j = 0; j < 10; ++j) {
                        const int kbase = (j == 0) ? 0 : 16 + 16 * (mt + j - 1);
                        const LAS unsigned char* kp = lds + (kbase + fr) * KS_STRIDE + fq * 16;
                        const bf16x8 k0 = *(const LAS bf16x8*)(kp), k1 = *(const LAS bf16x8*)(kp + 64);
                        f32x4 s = (f32x4){0.f, 0.f, 0.f, 0.f};
                        s = __builtin_amdgcn_mfma_f32_16x16x32_bf16(k0, qfr0, s, 0, 0, 0);
                        s = __builtin_amdgcn_mfma_f32_16x16x32_bf16(k1, qfr1, s, 0, 0, 0);
                        st[j] = s;
                    }
#pragma unroll
                    for (int r = 0; r < 4; ++r) { const int d1 = 4 * fq + r - fr; st[1][r] = (d1 >= 1) ? st[1][r] : -1e30f; st[9][r] = (d1 <= 0) ? st[9][r] : -1e30f; }
                    if (qb == 0) {
#pragma unroll
                        for (int j = 1; j < 10; ++j)
#pragma unroll
                            for (int r = 0; r < 4; ++r) st[j][r] = ((16 * (mt + j - 1) + 4 * fq + r) < 128) ? -1e30f : st[j][r];
                    }
                    float mx = sinkl;
#pragma unroll
                    for (int j = 0; j < 10; ++j) mx = fmaxf(fmaxf(mx, fmaxf(st[j][0], st[j][1])), fmaxf(st[j][2], st[j][3]));
                    mx = fmaxf(mx, __shfl_xor(mx, 16)); mx = fmaxf(mx, __shfl_xor(mx, 32));
                    float den = 0.f;
#pragma unroll
                    for (int j = 0; j < 10; ++j)
#pragma unroll
                        for (int r = 0; r < 4; ++r) { const float p = __builtin_amdgcn_exp2f(st[j][r] - mx); st[j][r] = p; den += p; }
                    den += __shfl_xor(den, 16); den += __shfl_xor(den, 32);
                    den += __builtin_amdgcn_exp2f(sinkl - mx);
                    const float rden = 1.0f / den;
                    f32x4 o[4];
#pragma unroll
                    for (int dt = 0; dt < 4; ++dt) o[dt] = (f32x4){0.f, 0.f, 0.f, 0.f};
#pragma unroll
                    for (int kp = 0; kp < 5; ++kp) {
                        u32x4 pw; pw.x = cvt_pk_bf16(st[2 * kp][0], st[2 * kp][1]); pw.y = cvt_pk_bf16(st[2 * kp][2], st[2 * kp][3]);
                        pw.z = cvt_pk_bf16(st[2 * kp + 1][0], st[2 * kp + 1][1]); pw.w = cvt_pk_bf16(st[2 * kp + 1][2], st[2 * kp + 1][3]);
                        const bf16x8 pfr = __builtin_bit_cast(bf16x8, pw);
                        const int kb0 = (kp == 0) ? 0 : 16 + 16 * (mt + 2 * kp - 1), kb1 = 16 + 16 * (mt + 2 * kp);
#pragma unroll
                        for (int dt = 0; dt < 4; ++dt) {
                            const LAS unsigned char* vp = lds + VT_OFF + (16 * dt + fr) * VT_STRIDE + 8 * fq;
                            const u32x2 va = *(const LAS u32x2*)(vp + 2 * kb0), vb = *(const LAS u32x2*)(vp + 2 * kb1);
                            const u32x4 vv = (u32x4){va.x, va.y, vb.x, vb.y};
                            o[dt] = __builtin_amdgcn_mfma_f32_16x16x32_bf16(__builtin_bit_cast(bf16x8, vv), pfr, o[dt], 0, 0, 0);
                        }
                    }
#pragma unroll
                    for (int dt = 0; dt < 4; ++dt) { u32x2 w; w.x = cvt_pk_bf16(o[dt][0] * rden, o[dt][1] * rden); w.y = cvt_pk_bf16(o[dt][2] * rden, o[dt][3] * rden);
                        *(u32x2*)(Ob + qrow * DM + h * 64 + 16 * dt + 4 * fq) = w; }
                }
                __syncthreads();
            }
        }
        if (IN(4)) {
            constexpr int AT_STRIDE = 528  , WL_OFF = 67584, AB_OFF = 101376, BB_OFF = 117888, SEG_OFF = 134400, CARRY_OFF = 138496, GC_OFF = 138752, CW_OFF = 139136, ABS = 129  ;
            static_assert(CW_OFF + 5120 <= LDS_BYTES, "LRU LDS map");
            const int fr = lane & 15, fq = lane >> 4;
            for (int itb = bid; itb < 256; itb += G) {
                const int item = (G == 256) ? (itb & 7) * 32 + (itb >> 3) : itb;
                const int b = item >> 6, n = (item >> 3) & 7, d0 = (item & 7) * 32, cb = n * 256 + d0;
                const int cg8 = tid & 31, seg = tid >> 5; const int cch = n * 256 + cg8 * 8;
                {
                    u32x4 wtmp[4]; float ctmp[3], gtmp[3];
#pragma unroll
                    for (int k = 0; k < 4; ++k) { const int i = tid + k * NTHREADS, gate = i >> 10, dd = (i >> 5) & 31, kc = i & 31;
                        wtmp[k] = *(const u32x4*)((gate ? Wt_i : Wt_a) + (size_t)(n * 256 + d0 + dd) * 256 + kc * 8); }
#pragma unroll
                    for (int k = 0; k < 3; ++k) { const int i = tid + k * NTHREADS, ic = i < 1280 ? i : 1279, tp = ic >> 8, c = ic & 255;
                        const float* src = (tp < 4) ? a.conv_w + tp * DM + n * 256 + c : a.conv_b + n * 256 + c; ctmp[k] = *src; }
                    { const int ch = cb + (tid & 31); gtmp[0] = a.lru_lambda[ch]; gtmp[1] = a.lru_ba[ch]; gtmp[2] = a.lru_bi[ch]; }
#pragma unroll
                    for (int k = 0; k < 4; ++k) { const int i = tid + k * NTHREADS, gate = i >> 10, dd = (i >> 5) & 31, kc = i & 31;
                        *(LAS u32x4*)(lds + WL_OFF + (gate * 32 + dd) * AT_STRIDE + kc * 16) = wtmp[k]; }
#pragma unroll
                    for (int k = 0; k < 3; ++k) { const int i = tid + k * NTHREADS; if (i < 1280) ((LAS float*)(lds + CW_OFF))[i] = ctmp[k]; }
                    if (tid < 32) { const float lam = gtmp[0];
                        ((LAS float*)(lds + GC_OFF))[tid] = (lam > 15.f) ? __expf(-lam) : log1pf(__expf(-lam)); ((LAS float*)(lds + GC_OFF))[32 + tid] = gtmp[1]; ((LAS float*)(lds + GC_OFF))[64 + tid] = gtmp[2]; }
                    if (tid < 64) ((LAS float*)(lds + CARRY_OFF))[tid] = 0.f;
                }
                __syncthreads();
                const u32x4 zero4 = (u32x4){0u, 0u, 0u, 0u};
                const int sch0 = tid & 31, seg0 = seg, fr0 = fr, fq0 = fq, cg80 = cg8;
#define LRU_LOAD_ROWS(TI) do { const bf16_t* base_ = LX + ((long)(b * 2064 + ((TI) == 0 ? 0 : 16 + ((TI) - 1) * 128) + seg * 8 - 3)) * DM + cch; \
                    _Pragma("unroll") for (int q_ = 0; q_ < 11; ++q_) { const bool ok_ = !((TI) == 0 && seg == 0 && q_ < 3); lxr[q_] = zero4; if (ok_) lxr[q_] = *(const u32x4*)(base_ + (long)q_ * DM); } } while (0)
                u32x4 lxr[11];
                LRU_LOAD_ROWS(0);
#pragma unroll 1
                for (int ti = 0; ti < 17; ++ti) {
                    int seg = seg0, sch = sch0, fr = fr0, fq = fq0, cg8 = cg80;
                    asm volatile("" : "+v"(seg), "+v"(sch), "+v"(fr), "+v"(fq), "+v"(cg8));
                    {
                        f32x2 win[3][4], cw[4][4], cbias[4];
#pragma unroll
                        for (int p = 0; p < 4; ++p) { win[0][p] = (f32x2){0.f, 0.f}; win[1][p] = (f32x2){0.f, 0.f}; win[2][p] = (f32x2){0.f, 0.f}; }
#pragma unroll
                        for (int tp = 0; tp < 5; ++tp) { const f32x4 c0 = *(const LAS f32x4*)(lds + CW_OFF + (tp * 256 + cg8 * 8) * 4), c1 = *(const LAS f32x4*)(lds + CW_OFF + (tp * 256 + cg8 * 8 + 4) * 4);
                            if (tp < 4) { cw[tp & 3][0] = (f32x2){c0[0], c0[1]}; cw[tp & 3][1] = (f32x2){c0[2], c0[3]}; cw[tp & 3][2] = (f32x2){c1[0], c1[1]}; cw[tp & 3][3] = (f32x2){c1[2], c1[3]}; }
                            else { cbias[0] = (f32x2){c0[0], c0[1]}; cbias[1] = (f32x2){c0[2], c0[3]}; cbias[2] = (f32x2){c1[0], c1[1]}; cbias[3] = (f32x2){c1[2], c1[3]}; } }
#pragma unroll
                        for (int q = 0; q < 11; ++q) {
                            const u32x4 w = lxr[q];
                            const f32x2 cur[4] = {(f32x2){bf_lo(w.x), bf_hi(w.x)}, (f32x2){bf_lo(w.y), bf_hi(w.y)}, (f32x2){bf_lo(w.z), bf_hi(w.z)}, (f32x2){bf_lo(w.w), bf_hi(w.w)}};
                            if (q >= 3) {
                                f32x2 y[4];
#pragma unroll
                                for (int p = 0; p < 4; ++p) y[p] = __builtin_elementwise_fma(cur[p], cw[3][p], __builtin_elementwise_fma(win[2][p], cw[2][p], __builtin_elementwise_fma(win[1][p], cw[1][p], __builtin_elementwise_fma(win[0][p], cw[0][p], cbias[p]))));
                                u32x4 o; o.x = cvt_pk_bf16(y[0][0], y[0][1]); o.y = cvt_pk_bf16(y[1][0], y[1][1]); o.z = cvt_pk_bf16(y[2][0], y[2][1]); o.w = cvt_pk_bf16(y[3][0], y[3][1]);
                                *(LAS u32x4*)(lds + (seg * 8 + q - 3) * AT_STRIDE + cg8 * 16) = o;
                            }
#pragma unroll
                            for (int p = 0; p < 4; ++p) { win[0][p] = win[1][p]; win[1][p] = win[2][p]; win[2][p] = cur[p]; }
                        }
                    }
                    const size_t row0 = (size_t)(b * SEQ + (ti > 0 ? ti - 1 : 0) * 128 + 8 * seg);
                    unsigned lgv[8];
                    { const bf16_t* lgp = LG + row0 * DM + cb + sch;
#pragma unroll
                      for (int j = 0; j < 8; ++j) lgv[j] = lgp[(size_t)j * DM]; }
                    { const int tn = ti < 16 ? ti + 1 : 16; LRU_LOAD_ROWS(tn); }
                    WG_BAR();
                    {
                        f32x4 acc[2][2];
#pragma unroll
                        for (int gt = 0; gt < 2; ++gt)
#pragma unroll
                            for (int nt = 0; nt < 2; ++nt) acc[gt][nt] = (f32x4){0.f, 0.f, 0.f, 0.f};
#pragma unroll
                        for (int ks = 0; ks < 8; ++ks) {
                            const bf16x8 af = *(const LAS bf16x8*)(lds + (16 * wave + fr) * AT_STRIDE + ks * 64 + fq * 16);
#pragma unroll
                            for (int gt = 0; gt < 2; ++gt)
#pragma unroll
                                for (int nt = 0; nt < 2; ++nt) {
                                    const bf16x8 wf = *(const LAS bf16x8*)(lds + WL_OFF + (gt * 32 + 16 * nt + fr) * AT_STRIDE + ks * 64 + fq * 16);
                                    acc[gt][nt] = __builtin_amdgcn_mfma_f32_16x16x32_bf16(wf, af, acc[gt][nt], 0, 0, 0);
                                }
                        }
                        const int tk = 16 * wave + fr;
#pragma unroll
                        for (int nt = 0; nt < 2; ++nt)
#pragma unroll
                            for (int r = 0; r < 4; ++r) {
                                const int ch = 16 * nt + 4 * fq + r;
                                const float splv = ((LAS float*)(lds + GC_OFF))[ch], bavv = ((LAS float*)(lds + GC_OFF))[32 + ch], bivv = ((LAS float*)(lds + GC_OFF))[64 + ch];
                                const float rg = fast_sigmoid(acc[0][nt][r] + bavv), ig = fast_sigmoid(acc[1][nt][r] + bivv);
                                const float la = -8.0f * rg * splv;
                                const float av = __builtin_amdgcn_exp2f(la * LOG2E);
                                const float t2 = 2.0f * la;
                                const float m2s = -t2 * (1.0f + t2 * (0.5f + t2 * (0.16666667f + t2 * (0.041666668f + t2 * (0.0083333338f + t2 * 0.0013888889f)))));
                                const float m2 = (t2 > -0.25f) ? m2s : (1.0f - av * av);
                                float mult = __builtin_amdgcn_sqrtf(fmaxf(m2, 0.f));
                                if (ti == 0 && tk == 0) mult = 1.0f;
                                const float xv = bf2f(*(const LAS bf16_t*)(lds + tk * AT_STRIDE + (d0 + ch) * 2));
                                ((LAS float*)(lds + AB_OFF))[ch * ABS + tk] = av;
                                ((LAS float*)(lds + BB_OFF))[ch * ABS + tk] = mult * ig * xv;
                            }
                    }
                    WG_BAR();
                    {
                        float A = 1.f, H = 0.f;
#pragma unroll
                        for (int j = 0; j < 8; ++j) { const float av = ((LAS float*)(lds + AB_OFF))[sch * ABS + 8 * seg + j], bv = ((LAS float*)(lds + BB_OFF))[sch * ABS + 8 * seg + j]; H = av * H + bv; A *= av; }
                        ((LAS f32x2*)(lds + SEG_OFF))[seg * 32 + sch] = (f32x2){A, H};
                    }
                    WG_BAR();
                    {
#pragma unroll
                        for (int j = 0; j < 8; ++j) asm volatile("" : "+v"(lgv[j]));
                        float hst = ((LAS float*)(lds + CARRY_OFF))[(ti & 1) * 32 + sch];
                        f32x2 shs[15];
#pragma unroll
                        for (int s2 = 0; s2 < 15; ++s2) shs[s2] = ((LAS f32x2*)(lds + SEG_OFF))[s2 * 32 + sch];
#pragma unroll
                        for (int s2 = 0; s2 < 15; ++s2) hst = (s2 < seg) ? shs[s2].x * hst + shs[s2].y : hst;
#pragma unroll
                        for (int j = 0; j < 8; ++j) { const float av = ((LAS float*)(lds + AB_OFF))[sch * ABS + 8 * seg + j], bv = ((LAS float*)(lds + BB_OFF))[sch * ABS + 8 * seg + j]; hst = av * hst + bv;
                            if (ti > 0) REC[(row0 + j) * DM + cb + sch] = (bf16_t)(cvt_pk_bf16(__uint_as_float(lgv[j] << 16) * hst, 0.f) & 0xffffu); }
                        const int lastseg = (ti == 0) ? 1 : 15;
                        if (seg == lastseg) ((LAS float*)(lds + CARRY_OFF))[((ti + 1) & 1) * 32 + sch] = hst;
                    }
                }
#undef LRU_LOAD_ROWS
                __syncthreads();
            }
        }
    }
    SEAM(4);

    if (IN(5)) {
        SchedMix S{(const char*)Ob, (const char*)REC, (const char*)Wt_oa, (const char*)Wt_ol, G, bid};
        EpiMix E{GA, GL, MIX};
        pg8::gemm_phase<EpiMix, SchedMix, true>(lds, 2 * DM, S, E);
    }
    SEAM(5);

    if (IN(6)) {
        SchedPlain S{(const char*)MIX, (const char*)Wt_out, 32, 8, DM, G, bid};
        EpiRes E{a.x, a.norm2_g, a.out, HG, rowss, a.flags & 1};
        pg8::gemm_phase<EpiRes, SchedPlain>(lds, DM, S, E);
    }
    SEAM(6);

    if (IN(7)) {
        SchedPlain S{(const char*)HG, (const char*)Wt_up, 32, 32, DM, G, bid};
        EpiUp E{rowss, U};
        pg8::gemm_phase<EpiUp, SchedPlain>(lds, DM, S, E);
    }
    SEAM(7);

    if (IN(8)) {
        SchedPlain S{(const char*)U, (const char*)Wt_dn, 32, 8, FF, G, bid};
        EpiDown E{a.out, a.flags & 2};
        pg8::gemm_phase<EpiDown, SchedPlain>(lds, FF, S, E);
    }
#undef IN
#undef SEAM
}

extern "C" void kernel_launch(void* const* d_in, const int* in_sizes, int n_in, void* d_out, int out_size, void* d_ws, size_t ws_size, hipStream_t stream) {
    static int grid = 0;
    if (grid == 0) {
        if (n_in != 20 || ws_size < WS_END) { fprintf(stderr, "kernel_launch: unexpected inputs (n_in %d, ws %zu)\n", n_in, ws_size); grid = -1; return; }
        int dev = 0, cus = 0, per_cu = 0;
        hipGetDevice(&dev);
        hipDeviceGetAttribute(&cus, hipDeviceAttributeMultiprocessorCount, dev);
        if (hipFuncSetAttribute((const void*)fwd_kernel, hipFuncAttributeMaxDynamicSharedMemorySize, LDS_BYTES) != hipSuccess) { fprintf(stderr, "kernel_launch: hipFuncSetAttribute failed\n"); grid = -1; return; }
        if (hipOccupancyMaxActiveBlocksPerMultiprocessor(&per_cu, (const void*)fwd_kernel, NTHREADS, LDS_BYTES) != hipSuccess || per_cu < 1) { fprintf(stderr, "kernel_launch: occupancy query says %d\n", per_cu); per_cu = 1; }
        (void)hipGetLastError();
        grid = cus * per_cu;
    }
    if (grid < 0) return;
    Args a{};
    a.x = (const float*)d_in[0]; a.meta = (const float*)d_in[1]; a.norm1_g = (const float*)d_in[2]; a.w_in = (const float*)d_in[3];
    a.q_norm_g = (const float*)d_in[4]; a.k_norm_g = (const float*)d_in[5]; a.sinks = (const float*)d_in[6]; a.w_o_attn = (const float*)d_in[7];
    a.conv_w = (const float*)d_in[8]; a.conv_b = (const float*)d_in[9]; a.lru_wa = (const float*)d_in[10]; a.lru_ba = (const float*)d_in[11];
    a.lru_wi = (const float*)d_in[12]; a.lru_bi = (const float*)d_in[13]; a.lru_lambda = (const float*)d_in[14]; a.w_o_lru = (const float*)d_in[15];
    a.w_out = (const float*)d_in[16]; a.norm2_g = (const float*)d_in[17]; a.w_up = (const float*)d_in[18]; a.w_down = (const float*)d_in[19];
    a.out = (float*)d_out; a.ws = (unsigned char*)d_ws;
    if (hipMemsetAsync((unsigned char*)d_ws + WS_BAR, 0, WS_BAR_BYTES, stream) != hipSuccess) { fprintf(stderr, "kernel_launch: memset of the barrier words failed\n"); return; }
#if MK_MULTI
    for (int ph = 0; ph < 9; ++ph) {
        a.ph_lo = ph; a.ph_hi = ph + 1; a.flags = 0;
        void* args[] = {&a};
        hipError_t e = hipLaunchCooperativeKernel((const void*)fwd_kernel, dim3(grid), dim3(NTHREADS), args, LDS_BYTES, stream);
        if (e != hipSuccess) { fprintf(stderr, "cooperative launch (phase %d) failed: %s (grid %d)\n", ph, hipGetErrorString(e), grid); break; }
    }
#elif PROBE_DUP >= 0
    for (int li = 0; li < 2; ++li) {
        a.ph_lo = li ? PROBE_DUP : 0; a.ph_hi = li ? 9 : PROBE_DUP + 1; a.flags = (li << 8) | (li ? 0 : (PROBE_DUP == 6 ? 1 : (PROBE_DUP == 8 ? 2 : 0)));
        void* args[] = {&a};
        hipError_t e = hipLaunchCooperativeKernel((const void*)fwd_kernel, dim3(grid), dim3(NTHREADS), args, LDS_BYTES, stream);
        if (e != hipSuccess) { fprintf(stderr, "cooperative launch failed: %s (grid %d)\n", hipGetErrorString(e), grid); break; }
    }
#else
    a.ph_lo = 0; a.ph_hi = 9;
    void* args[] = {&a};
    hipError_t e = hipLaunchCooperativeKernel((const void*)fwd_kernel, dim3(grid), dim3(NTHREADS), args, LDS_BYTES, stream);
    if (e != hipSuccess) fprintf(stderr, "cooperative launch failed: %s (grid %d)\n", hipGetErrorString(e), grid);
#endif
}
```
